# Optimizing an MI355X kernel written in HIP

```python
import jax, jax.numpy as jnp
from jax import lax
import numpy as np

D_MODEL = 1024
BATCH = 8
SEQ = 2048
DEPTH = 4

GRID_W = 64
CTX_LEN = 256
N_MIXERS = 4
ROPE_BASE = 10000.0
Q_BLOCK = 128
NORM_EPS = 1e-6
FFN_DIM = 4 * D_MODEL
ADALN_CHUNKS = 6

GQA_HEAD_DIM = 64
GQA_HEADS = D_MODEL // GQA_HEAD_DIM
GQA_KV_HEADS = GQA_HEADS // 4

RWKV_HEAD = 64
RWKV_HEADS = D_MODEL // RWKV_HEAD
RWKV_DECAY_LORA = 64
RWKV_A_LORA = 64
RWKV_G_LORA = 128
RWKV_GN_EPS = 64e-5

MLA_HEADS = 16
MLA_Q_RANK = D_MODEL // 2
MLA_KV_RANK = D_MODEL // 4
MLA_NOPE = 64
MLA_ROPE = 32
MLA_V = D_MODEL // MLA_HEADS

GLA_HEADS = 4
GLA_DK = D_MODEL // 2 // GLA_HEADS
GLA_DV = D_MODEL // GLA_HEADS
GLA_GATE_RANK = 16
GLA_TAU = 16.0
GLA_CHUNK = 64

kernel_name = 'hybrid_flow_backbone'


def rms_norm(x, g, eps=NORM_EPS):
    xf = x.astype(jnp.float32)
    y = xf * lax.rsqrt(jnp.mean(xf * xf, axis=-1, keepdims=True) + eps)
    return (y * g.astype(jnp.float32)).astype(x.dtype)


def modulate(u, shift, scale):
    return u * (1 + scale) + shift


def sq_relu_mlp(u, w_up, w_down):
    return jnp.square(jax.nn.relu(u @ w_up)) @ w_down


def grid_rope(rows, rot_dim, dtype):
    row = jnp.repeat(jnp.arange(rows), GRID_W).astype(jnp.float32)
    col = jnp.tile(jnp.arange(GRID_W), rows).astype(jnp.float32)
    n_freq = rot_dim // 4
    inv_freq = ROPE_BASE ** (-jnp.arange(n_freq, dtype=jnp.float32) / n_freq)
    ang = jnp.concatenate([row[:, None] * inv_freq, col[:, None] * inv_freq], axis=-1)
    return jnp.cos(ang).astype(dtype), jnp.sin(ang).astype(dtype)


def apply_rope(x, cos, sin):
    half = x.shape[-1] // 2
    x1, x2 = x[..., :half], x[..., half:]
    c, s = cos[:, None, :], sin[:, None, :]
    return jnp.concatenate([x1 * c - x2 * s, x1 * s + x2 * c], axis=-1)


def attend(q, k, v, scale):
    B, Tq, H, dq = q.shape
    Hk = k.shape[2]
    qg = q.reshape(B, Tq, Hk, H // Hk, dq)
    s = jnp.einsum('bqkgd,blkd->bkgql', qg, k).astype(jnp.float32) * scale
    p = jax.nn.softmax(s, axis=-1).astype(v.dtype)
    o = jnp.einsum('bkgql,blkd->bqkgd', p, v)
    return o.reshape(B, Tq, H, v.shape[-1])


def block_attention(q, k, v, scale):
    B, T, H, dq = q.shape
    qb = jnp.moveaxis(q.reshape(B, T // Q_BLOCK, Q_BLOCK, H, dq), 1, 0)
    ob = lax.map(lambda qi: attend(qi, k, v, scale), qb)
    return jnp.moveaxis(ob, 0, 1).reshape(B, T, H, v.shape[-1])


def attend_streams(q_c, k_c, v_c, q_x, k_x, v_x, scale, w_out):
    B, S = q_x.shape[:2]
    k_all = jnp.concatenate([k_c, k_x], axis=1)
    v_all = jnp.concatenate([v_c, v_x], axis=1)
    y_x = block_attention(q_x, k_all, v_all, scale).reshape(B, S, -1) @ w_out
    if q_c is None:
        return None, y_x
    y_c = block_attention(q_c, k_c, v_c, scale).reshape(B, q_c.shape[1], -1) @ w_out
    return y_c, y_x


def gqa_mixer(u_c, u_x, w_in, q_gain, k_gain, w_out, rope, with_ctx_out):
    hd = GQA_HEAD_DIM
    nq, nkv = GQA_HEADS * hd, GQA_KV_HEADS * hd

    def project(u, pos, with_q):
        B, T, _ = u.shape
        off = nq if with_q else 0
        z = u @ (w_in if with_q else w_in[:, nq:])
        k = rms_norm(z[..., off:off + nkv].reshape(B, T, GQA_KV_HEADS, hd), k_gain)
        v = z[..., off + nkv:].reshape(B, T, GQA_KV_HEADS, hd)
        if pos is not None:
            k = apply_rope(k, *pos)
        if not with_q:
            return None, k, v
        q = rms_norm(z[..., :nq].reshape(B, T, GQA_HEADS, hd), q_gain)
        if pos is not None:
            q = apply_rope(q, *pos)
        return q, k, v

    q_c, k_c, v_c = project(u_c, None, with_ctx_out)
    q_x, k_x, v_x = project(u_x, rope, True)
    return attend_streams(q_c, k_c, v_c, q_x, k_x, v_x, hd ** -0.5, w_out)


def mla_mixer(u_c, u_x, w_in, q_gain, kv_gain, w_uq, w_ukv, w_out, rope, with_ctx_out):
    H = MLA_HEADS

    def project(u, pos, with_q):
        B, T, _ = u.shape
        z = u @ (w_in if with_q else w_in[:, MLA_Q_RANK:])
        z_kv = z[..., z.shape[-1] - MLA_KV_RANK - MLA_ROPE:]
        kv = (rms_norm(z_kv[..., :MLA_KV_RANK], kv_gain) @ w_ukv).reshape(B, T, H, MLA_NOPE + MLA_V)
        k_rope = z_kv[..., MLA_KV_RANK:][:, :, None, :]
        if pos is not None:
            k_rope = apply_rope(k_rope, *pos)
        k = jnp.concatenate([kv[..., :MLA_NOPE], jnp.broadcast_to(k_rope, (B, T, H, MLA_ROPE))], axis=-1)
        v = kv[..., MLA_NOPE:]
        if not with_q:
            return None, k, v
        q = (rms_norm(z[..., :MLA_Q_RANK], q_gain) @ w_uq).reshape(B, T, H, MLA_NOPE + MLA_ROPE)
        if pos is not None:
            q = jnp.concatenate([q[..., :MLA_NOPE], apply_rope(q[..., MLA_NOPE:], *pos)], axis=-1)
        return q, k, v

    q_c, k_c, v_c = project(u_c, None, with_ctx_out)
    q_x, k_x, v_x = project(u_x, rope, True)
    return attend_streams(q_c, k_c, v_c, q_x, k_x, v_x, (MLA_NOPE + MLA_ROPE) ** -0.5, w_out)


def centred_shift(u):
    prev = jnp.pad(u[:, :-1], ((0, 0), (1, 0), (0, 0)))
    nxt = jnp.pad(u[:, 1:], ((0, 0), (0, 1), (0, 0)))
    return 0.5 * (prev + nxt)


def rwkv_side(u, mu, w_rkv, w0, w1, w2, a0, a1, a2, g1, g2, k_k, k_a, with_out):
    B, T, D = u.shape
    H, N = RWKV_HEADS, RWKV_HEAD
    xx = centred_shift(u) - u
    mix = lambda i: u + xx * mu[i]
    xw, xk, xv, xa = mix(1), mix(2), mix(3), mix(4)
    k = xk @ w_rkv[1]
    v = xv @ w_rkv[2]
    lora = lambda xin, wa, wb: jnp.einsum('nbtr,nrd->nbtd', xin, wb) if wa is None else None
    w_log = -jax.nn.softplus(-(w0[:, None, None, :] + jnp.einsum('nbtr,nrd->nbtd', jnp.tanh(jnp.einsum('btd,ndr->nbtr', xw, w1)), w2))) - 0.5
    a = jax.nn.sigmoid(a0[:, None, None, :] + jnp.einsum('nbtr,nrd->nbtd', jnp.einsum('btd,ndr->nbtr', xa, a1), a2))
    kk = (k * k_k).reshape(B, T, H, N).astype(jnp.float32)
    kk = (kk / jnp.maximum(jnp.sqrt(jnp.sum(kk * kk, axis=-1, keepdims=True)), 1e-12)).reshape(B, T, D)
    k_dir = k[None] * (1 + (a - 1) * k_a)
    decay = jnp.exp(-jnp.exp(w_log.astype(jnp.float32)))

    def lay(t):
        t = jnp.stack([t[0], jnp.flip(t[1], axis=1)]).astype(jnp.float32)
        return jnp.moveaxis(t.reshape(2, B, T, H, N), 2, 0)

    both = lambda t: jnp.stack([t, t])
    scan_in = (lay(decay), lay(k_dir), lay(both(v)), lay(both(-kk)), lay(kk[None] * a))
    if not with_out:
        return scan_in, None
    r = mix(0) @ w_rkv[0]
    g = jax.nn.sigmoid(mix(5) @ g1) @ g2
    return scan_in + (lay(both(r)),), (r, k_dir, v, g)


def rwkv_scan(scan_in, S0, with_out):
    def step(S, inp):
        w_t, k_t, v_t, a_t, b_t = inp[:5]
        sa = jnp.einsum('dbhij,dbhj->dbhi', S, a_t)
        S = S * w_t[..., None, :] + sa[..., :, None] * b_t[..., None, :] + v_t[..., :, None] * k_t[..., None, :]
        return S, (jnp.einsum('dbhij,dbhj->dbhi', S, inp[5]) if with_out else None)

    S, ys = lax.scan(step, S0, scan_in)
    if not with_out:
        return S, None
    ys = jnp.moveaxis(ys, 0, 2)
    return S, ys[0] + jnp.flip(ys[1], axis=1)


def rwkv_out(y, r, k_dir, v, g, r_k, ln_w, ln_b, w_out):
    B, T, H, N = y.shape
    mean = jnp.mean(y, axis=-1, keepdims=True)
    var = jnp.mean(jnp.square(y - mean), axis=-1, keepdims=True)
    yn = ((y - mean) * lax.rsqrt(var + RWKV_GN_EPS)).reshape(B, T, H * N) * ln_w + ln_b
    rk = jnp.sum((r[None] * k_dir).reshape(2, B, T, H, N) * r_k, axis=(0, -1))[..., None]
    yn = yn + (rk * v.reshape(B, T, H, N)).reshape(B, T, H * N)
    return (yn.astype(v.dtype) * g) @ w_out


def rwkv_mixer(u_c, u_x, mu, w_rkv, w0, w1, w2, a0, a1, a2, g1, g2, k_k, k_a, r_k, ln_w, ln_b, w_out, with_ctx_out):
    B = u_x.shape[0]
    side = lambda u, wo: rwkv_side(u, mu, w_rkv, w0, w1, w2, a0, a1, a2, g1, g2, k_k, k_a, wo)
    in_c, aux_c = side(u_c, with_ctx_out)
    S0 = jnp.zeros((2, B, RWKV_HEADS, RWKV_HEAD, RWKV_HEAD), jnp.float32)
    S_c, y_c = rwkv_scan(in_c, S0, with_ctx_out)
    in_x, aux_x = side(u_x, True)
    _, y_x = rwkv_scan(in_x, S_c, True)
    out_x = rwkv_out(y_x, *aux_x, r_k, ln_w, ln_b, w_out)
    if not with_ctx_out:
        return None, out_x
    return rwkv_out(y_c, *aux_c, r_k, ln_w, ln_b, w_out), out_x


def gla_side(u, w_in, gate_down, gate_up, gate_bias, with_out):
    B, T, _ = u.shape
    H, dk, dv = GLA_HEADS, GLA_DK, GLA_DV
    nk, nv = H * dk, H * dv
    off = nk if with_out else 0
    z = u @ (w_in if with_out else w_in[:, nk:2 * nk + nv])
    k = z[..., off:off + nk]
    v = z[..., off + nk:off + nk + nv]
    g_lin = jnp.einsum('nbtr,nrk->nbtk', jnp.einsum('btd,ndr->nbtr', u, gate_down), gate_up) + gate_bias[:, None, None, :]
    g = jax.nn.log_sigmoid(g_lin.astype(jnp.float32)) / GLA_TAU

    def lay(t, d):
        t = jnp.stack([t[0], jnp.flip(t[1], axis=1)]).astype(jnp.float32)
        return jnp.moveaxis(t.reshape(2, B, T // GLA_CHUNK, GLA_CHUNK, H, d), 2, 0)

    both = lambda t: jnp.stack([t, t])
    scan_in = (lay(both(k), dk), lay(both(v), dv), lay(g, dk))
    if not with_out:
        return scan_in, None
    q = z[..., :nk] * dk ** -0.5
    return scan_in + (lay(both(q), dk),), z[..., 2 * nk + nv:]


def gla_scan(scan_in, S0, with_out):
    C = GLA_CHUNK
    causal = jnp.tril(jnp.ones((C, C), dtype=bool))[:, :, None, None]

    def step(S, inp):
        k_c, v_c, g_c = inp[:3]
        b = jnp.cumsum(g_c, axis=2)
        b_last = b[:, :, -1]
        S_new = S * jnp.exp(b_last)[..., None] + jnp.einsum('xbshk,xbshv->xbhkv', k_c * jnp.exp(b_last[:, :, None] - b), v_c)
        if not with_out:
            return S_new, None
        q_c = inp[3]
        o = jnp.einsum('xbthk,xbhkv->xbthv', q_c * jnp.exp(b), S)
        dec = jnp.exp(jnp.where(causal, b[:, :, :, None] - b[:, :, None, :], -jnp.inf))
        att = jnp.einsum('xbtshk,xbshk->xbhts', q_c[:, :, :, None] * dec, k_c)
        o = o + jnp.einsum('xbhts,xbshv->xbthv', att, v_c)
        return S_new, o

    S, ys = lax.scan(step, S0, scan_in)
    if not with_out:
        return S, None
    n, _, B, _, H, dv = ys.shape
    ys = jnp.moveaxis(ys, 0, 2).reshape(2, B, n * C, H, dv)
    return S, ys[0] + jnp.flip(ys[1], axis=1)


def gla_out(o, gout, o_gain, w_out):
    B, T, H, dv = o.shape
    o = rms_norm(o, o_gain).reshape(B, T, H * dv).astype(gout.dtype)
    return (o * jax.nn.silu(gout)) @ w_out


def gla_mixer(u_c, u_x, w_in, gate_down, gate_up, gate_bias, o_gain, w_out, with_ctx_out):
    B = u_x.shape[0]
    in_c, gout_c = gla_side(u_c, w_in, gate_down, gate_up, gate_bias, with_ctx_out)
    S0 = jnp.zeros((2, B, GLA_HEADS, GLA_DK, GLA_DV), jnp.float32)
    S_c, o_c = gla_scan(in_c, S0, with_ctx_out)
    in_x, gout_x = gla_side(u_x, w_in, gate_down, gate_up, gate_bias, True)
    _, o_x = gla_scan(in_x, S_c, True)
    y_x = gla_out(o_x, gout_x, o_gain, w_out)
    if not with_ctx_out:
        return None, y_x
    return gla_out(o_c, gout_c, o_gain, w_out), y_x


def setup_inputs(seed: int = 0) -> dict:
    key = jax.random.key(seed)
    keys = iter(jax.random.split(key, 128))
    D = D_MODEL

    def nrm(shape, std):
        return std * jax.random.normal(next(keys), shape, jnp.float32)

    def lin(*shape):
        return nrm(shape, shape[-2] ** -0.5)

    def gain(n):
        return 1.0 + nrm((n,), 0.05)

    p = {}
    p['x'] = nrm((BATCH, SEQ, D), 1.0)
    p['c'] = nrm((BATCH, D), 1.0)
    p['ctx'] = nrm((BATCH, CTX_LEN, D), 1.0)
    p['c_ctx'] = nrm((D,), 1.0)

    def head(i):
        p[f'l{i}_ada_w'] = nrm((D, ADALN_CHUNKS * D), 0.5 * D ** -0.5)
        p[f'l{i}_ada_b'] = nrm((ADALN_CHUNKS * D,), 0.02)
        p[f'l{i}_norm1'] = gain(D)

    def tail(i):
        p[f'l{i}_norm2'] = gain(D)
        p[f'l{i}_mlp_up'] = lin(D, FFN_DIM)
        p[f'l{i}_mlp_down'] = lin(FFN_DIM, D)

    head(0)
    p['l0_w_in'] = lin(D, (GQA_HEADS + 2 * GQA_KV_HEADS) * GQA_HEAD_DIM)
    p['l0_q_gain'] = gain(GQA_HEAD_DIM)
    p['l0_k_gain'] = gain(GQA_HEAD_DIM)
    p['l0_w_out'] = lin(GQA_HEADS * GQA_HEAD_DIM, D)
    tail(0)

    head(1)
    p['l1_mu'] = jax.random.uniform(next(keys), (6, D), jnp.float32)
    p['l1_w_rkv'] = lin(3, D, D)
    p['l1_w0'] = nrm((2, D), 0.3)
    p['l1_w1'] = nrm((2, D, RWKV_DECAY_LORA), 0.5 * D ** -0.5)
    p['l1_w2'] = nrm((2, RWKV_DECAY_LORA, D), 0.5 * RWKV_DECAY_LORA ** -0.5)
    p['l1_a0'] = nrm((2, D), 0.1)
    p['l1_a1'] = nrm((2, D, RWKV_A_LORA), 0.5 * D ** -0.5)
    p['l1_a2'] = nrm((2, RWKV_A_LORA, D), 0.5 * RWKV_A_LORA ** -0.5)
    p['l1_g1'] = lin(D, RWKV_G_LORA)
    p['l1_g2'] = lin(RWKV_G_LORA, D)
    p['l1_k_k'] = 0.85 + nrm((D,), 0.05)
    p['l1_k_a'] = 1.0 + nrm((D,), 0.05)
    p['l1_r_k'] = nrm((RWKV_HEADS, RWKV_HEAD), 0.1)
    p['l1_ln_w'] = gain(D)
    p['l1_ln_b'] = nrm((D,), 0.02)
    p['l1_w_out'] = lin(D, D)
    tail(1)

    head(2)
    p['l2_w_in'] = lin(D, MLA_Q_RANK + MLA_KV_RANK + MLA_ROPE)
    p['l2_q_gain'] = gain(MLA_Q_RANK)
    p['l2_kv_gain'] = gain(MLA_KV_RANK)
    p['l2_w_uq'] = lin(MLA_Q_RANK, MLA_HEADS * (MLA_NOPE + MLA_ROPE))
    p['l2_w_ukv'] = lin(MLA_KV_RANK, MLA_HEADS * (MLA_NOPE + MLA_V))
    p['l2_w_out'] = lin(MLA_HEADS * MLA_V, D)
    tail(2)

    head(3)
    p['l3_w_in'] = lin(D, 2 * GLA_HEADS * GLA_DK + 2 * GLA_HEADS * GLA_DV)
    p['l3_gate_down'] = lin(2, D, GLA_GATE_RANK)
    p['l3_gate_up'] = lin(2, GLA_GATE_RANK, GLA_HEADS * GLA_DK)
    p['l3_gate_bias'] = nrm((2, GLA_HEADS * GLA_DK), 0.1)
    p['l3_o_gain'] = gain(GLA_DV)
    p['l3_w_out'] = lin(GLA_HEADS * GLA_DV, D)
    tail(3)

    p['final_norm'] = gain(D)
    return p


def reference(x, c, ctx, c_ctx,
              l0_ada_w, l0_ada_b, l0_norm1, l0_w_in, l0_q_gain, l0_k_gain, l0_w_out, l0_norm2, l0_mlp_up, l0_mlp_down,
              l1_ada_w, l1_ada_b, l1_norm1, l1_mu, l1_w_rkv, l1_w0, l1_w1, l1_w2, l1_a0, l1_a1, l1_a2, l1_g1, l1_g2,
              l1_k_k, l1_k_a, l1_r_k, l1_ln_w, l1_ln_b, l1_w_out, l1_norm2, l1_mlp_up, l1_mlp_down,
              l2_ada_w, l2_ada_b, l2_norm1, l2_w_in, l2_q_gain, l2_kv_gain, l2_w_uq, l2_w_ukv, l2_w_out, l2_norm2,
              l2_mlp_up, l2_mlp_down,
              l3_ada_w, l3_ada_b, l3_norm1, l3_w_in, l3_gate_down, l3_gate_up, l3_gate_bias, l3_o_gain, l3_w_out,
              l3_norm2, l3_mlp_up, l3_mlp_down,
              final_norm):
    B, S, _ = x.shape
    rows = S // GRID_W
    rope_a = grid_rope(rows, GQA_HEAD_DIM, x.dtype)
    rope_c = grid_rope(rows, MLA_ROPE, x.dtype)
    s_c = jax.nn.silu(c)
    s_cc = jax.nn.silu(c_ctx)

    layers = (
        ((l0_ada_w, l0_ada_b, l0_norm1, l0_norm2, l0_mlp_up, l0_mlp_down),
         lambda uc, ux, wo: gqa_mixer(uc, ux, l0_w_in, l0_q_gain, l0_k_gain, l0_w_out, rope_a, wo)),
        ((l1_ada_w, l1_ada_b, l1_norm1, l1_norm2, l1_mlp_up, l1_mlp_down),
         lambda uc, ux, wo: rwkv_mixer(uc, ux, l1_mu, l1_w_rkv, l1_w0, l1_w1, l1_w2, l1_a0, l1_a1, l1_a2, l1_g1, l1_g2,
                                       l1_k_k, l1_k_a, l1_r_k, l1_ln_w, l1_ln_b, l1_w_out, wo)),
        ((l2_ada_w, l2_ada_b, l2_norm1, l2_norm2, l2_mlp_up, l2_mlp_down),
         lambda uc, ux, wo: mla_mixer(uc, ux, l2_w_in, l2_q_gain, l2_kv_gain, l2_w_uq, l2_w_ukv, l2_w_out, rope_c, wo)),
        ((l3_ada_w, l3_ada_b, l3_norm1, l3_norm2, l3_mlp_up, l3_mlp_down),
         lambda uc, ux, wo: gla_mixer(uc, ux, l3_w_in, l3_gate_down, l3_gate_up, l3_gate_bias, l3_o_gain, l3_w_out, wo)),
    )

    h = ctx
    for i in range(DEPTH):
        (ada_w, ada_b, n1, n2, w_up, w_down), mixer = layers[i]
        last = i == DEPTH - 1
        mod_x = jnp.split((s_c @ ada_w + ada_b)[:, None, :], ADALN_CHUNKS, axis=-1)
        mod_c = jnp.split((s_cc @ ada_w + ada_b)[None, None, :], ADALN_CHUNKS, axis=-1)
        u_x = modulate(rms_norm(x, n1), mod_x[0], mod_x[1])
        u_c = modulate(rms_norm(h, n1), mod_c[0], mod_c[1])
        y_c, y_x = mixer(u_c, u_x, not last)
        x = x + mod_x[2] * y_x
        x = x + mod_x[5] * sq_relu_mlp(modulate(rms_norm(x, n2), mod_x[3], mod_x[4]), w_up, w_down)
        if not last:
            h = h + mod_c[2] * y_c
            h = h + mod_c[5] * sq_relu_mlp(modulate(rms_norm(h, n2), mod_c[3], mod_c[4]), w_up, w_down)
    return rms_norm(x, final_norm)
```

```cpp
#include <hip/hip_runtime.h>
#include <hip/hip_cooperative_groups.h>
#include <stdint.h>
#include <cstdio>
namespace cg = cooperative_groups;

#define DEVI __device__ __forceinline__
typedef unsigned short bfu;
using bf16x8 = __attribute__((ext_vector_type(8))) short;
using f32x16 = __attribute__((ext_vector_type(16))) float;
using f32x4 = __attribute__((ext_vector_type(4))) float;

constexpr int D = 1024, NB = 8, TT = 2304, CL = 256, M = NB * TT;
constexpr int NTHR = 256;
constexpr int LDS_BYTES = 75776;

constexpr size_t SLOT = (size_t)M * 1024 * 2;
constexpr size_t OFF_W = 0;
constexpr size_t W_BYTES = 27262976;
constexpr size_t OFF_XR = OFF_W + W_BYTES;
constexpr size_t OFF_U = OFF_XR + (size_t)M * 1024 * 4;
constexpr size_t OFF_BIG = OFF_U + SLOT;
constexpr size_t OFF_EX = OFF_BIG + 4 * SLOT;
constexpr size_t OFF_TW = OFF_EX + SLOT;
constexpr size_t OFF_AA = OFF_TW + (size_t)M * 128 * 2;
constexpr size_t OFF_SG = OFF_AA + (size_t)M * 128 * 2;
constexpr size_t OFF_BON = OFF_SG + (size_t)M * 128 * 2;
constexpr size_t OFF_GD = OFF_BON + (size_t)2 * M * 16 * 4;
constexpr size_t OFF_SS = OFF_GD + (size_t)M * 32 * 4;
constexpr size_t OFF_MOD = OFF_SS + (size_t)M * 8 * 4;
constexpr size_t OFF_ROPEA = OFF_MOD + (size_t)4 * 9 * 6144 * 4;
constexpr size_t OFF_ROPEC = OFF_ROPEA + (size_t)2 * 2048 * 32 * 4;
constexpr size_t WS_BAR = OFF_ROPEC + (size_t)2 * 2048 * 16 * 4;
constexpr size_t WS_END = WS_BAR + 16384;

constexpr int WUP = 0, WDN = 4194304, MW = 8388608;
constexpr int WIN0 = MW, WOUT0 = MW + 1572864;
constexpr int W1CAT = MW, G2T = MW + 3538944, W2T = G2T + 131072, A2T = W2T + 131072, WOUT1 = A2T + 131072;
constexpr int WIN2 = MW, WUQ = MW + 917504, WUKV = WUQ + 786432, WOUT2 = WUKV + 524288;
constexpr int WIN3 = MW, WOUT3 = MW + 3276800;

struct Params {
  const float* in[61];
  float* out;
  unsigned char* ws;
  int ph_lo, ph_hi;
};

struct ConvJob { int in_idx, src_off, src_ld, K, ngroups, grp_w, grp_stride, dst_off, scale_idx; };

__constant__ ConvJob g_jobs[] = {
  {12, 0, 4096, 1024, 64, 64, 64, WUP, -1},
  {13, 0, 1024, 4096, 16, 64, 64, WDN, -1},
  {7, 0, 1536, 1024, 24, 64, 64, WIN0, -1},
  {10, 0, 1024, 1024, 16, 64, 64, WOUT0, -1},
  {34, 0, 4096, 1024, 64, 64, 64, WUP, -1},
  {35, 0, 1024, 4096, 16, 64, 64, WDN, -1},
  {18, 0, 1024, 1024, 16, 64, 64, W1CAT, -1},
  {18, 1048576, 1024, 1024, 16, 64, 64, W1CAT + 1024 * 1024, -1},
  {18, 2097152, 1024, 1024, 16, 64, 64, W1CAT + 2048 * 1024, -1},
  {20, 0, 64, 1024, 1, 64, 64, W1CAT + 3072 * 1024, -1},
  {20, 65536, 64, 1024, 1, 64, 64, W1CAT + 3136 * 1024, -1},
  {23, 0, 64, 1024, 1, 64, 64, W1CAT + 3200 * 1024, -1},
  {23, 65536, 64, 1024, 1, 64, 64, W1CAT + 3264 * 1024, -1},
  {25, 0, 128, 1024, 2, 64, 64, W1CAT + 3328 * 1024, -1},
  {26, 0, 1024, 128, 16, 64, 64, G2T, -1},
  {21, 0, 1024, 64, 16, 64, 64, W2T, -1},
  {21, 65536, 1024, 64, 16, 64, 64, W2T + 65536, -1},
  {24, 0, 1024, 64, 16, 64, 64, A2T, -1},
  {24, 65536, 1024, 64, 16, 64, 64, A2T + 65536, -1},
  {32, 0, 1024, 1024, 16, 64, 64, WOUT1, -1},
  {46, 0, 4096, 1024, 64, 64, 64, WUP, -1},
  {47, 0, 1024, 4096, 16, 64, 64, WDN, -1},
  {39, 0, 800, 1024, 25, 32, 32, WIN2, -1},
  {42, 0, 1536, 512, 16, 64, 96, WUQ, 40},
  {42, 64, 1536, 512, 16, 32, 96, WUQ + 1024 * 512, 40},
  {43, 0, 2048, 256, 16, 64, 128, WUKV, 41},
  {43, 64, 2048, 256, 16, 64, 128, WUKV + 1024 * 256, 41},
  {44, 0, 1024, 1024, 16, 64, 64, WOUT2, -1},
  {58, 0, 4096, 1024, 64, 64, 64, WUP, -1},
  {59, 0, 1024, 4096, 16, 64, 64, WDN, -1},
  {51, 0, 3072, 1024, 48, 64, 64, WIN3, -1},
  {52, 0, 16, 1024, 1, 16, 16, WIN3 + 3072 * 1024, -1},
  {52, 16384, 16, 1024, 1, 16, 16, WIN3 + 3088 * 1024, -1},
  {56, 0, 1024, 1024, 16, 64, 64, WOUT3, -1},
};
__constant__ int g_job_lo[5] = {0, 4, 20, 28, 34};

typedef __bf16 hwbf2 __attribute__((ext_vector_type(2)));
typedef float hwf2 __attribute__((ext_vector_type(2)));
DEVI unsigned pack2(float a, float b) {
  const hwf2 v = {a, b};
  return __builtin_bit_cast(unsigned, __builtin_convertvector(v, hwbf2));
}
DEVI unsigned short f2bf(float f) { return (unsigned short)(pack2(f, 0.f) & 0xffffu); }
DEVI float bf2f(unsigned short h) { return __uint_as_float(((unsigned)h) << 16); }
DEVI float bflo(unsigned w) { return __uint_as_float(w << 16); }
DEVI float bfhi(unsigned w) { return __uint_as_float(w & 0xffff0000u); }
DEVI void unpack8(const uint4& q, float* f) {
  f[0] = bflo(q.x); f[1] = bfhi(q.x); f[2] = bflo(q.y); f[3] = bfhi(q.y);
  f[4] = bflo(q.z); f[5] = bfhi(q.z); f[6] = bflo(q.w); f[7] = bfhi(q.w);
}
DEVI uint4 pack8(const float* f) {
  uint4 q; q.x = pack2(f[0], f[1]); q.y = pack2(f[2], f[3]); q.z = pack2(f[4], f[5]); q.w = pack2(f[6], f[7]);
  return q;
}
DEVI void store16bf(bfu* dst, const float* v) {
  *(uint4*)dst = pack8(v);
  *(uint4*)(dst + 8) = pack8(v + 8);
}
template <int CTRL>
DEVI float dpp_mov(float v) { return __int_as_float(__builtin_amdgcn_update_dpp(0, __float_as_int(v), CTRL, 0xF, 0xF, true)); }
DEVI float sum8(float v) {
  v += dpp_mov<0xB1>(v);
  v += dpp_mov<0x4E>(v);
  v += dpp_mov<0x141>(v);
  return v;
}
DEVI float xor1(float v) { return dpp_mov<0xB1>(v); }
DEVI float xor2(float v) { return dpp_mov<0x4E>(v); }
DEVI float sum4(float v) { v += xor1(v); v += xor2(v); return v; }
DEVI float sum16(float v) { v = sum8(v); v += dpp_mov<0x140>(v); return v; }
DEVI float wave_sum(float v) {
  v = sum8(v);
  v += dpp_mov<0x140>(v);
  const int vi = __float_as_int(v);
  const float r0 = __int_as_float(__builtin_amdgcn_readlane(vi, 0)), r1 = __int_as_float(__builtin_amdgcn_readlane(vi, 16));
  const float r2 = __int_as_float(__builtin_amdgcn_readlane(vi, 32)), r3 = __int_as_float(__builtin_amdgcn_readlane(vi, 48));
  return (r0 + r1) + (r2 + r3);
}
DEVI int4& xmap_ref() { __shared__ int4 m; return m; }
DEVI void load16f(const float* src, float* f) {
#pragma unroll
  for (int q = 0; q < 4; ++q) { const float4 t = *(const float4*)(src + 4 * q); f[4 * q] = t.x; f[4 * q + 1] = t.y; f[4 * q + 2] = t.z; f[4 * q + 3] = t.w; }
}
DEVI float fast_tanh(float x) { return 1.f - 2.f * __builtin_amdgcn_rcpf(1.f + __expf(2.f * x)); }
DEVI float sigmoidf_(float x) { return 1.f / (1.f + __expf(-x)); }
DEVI float softplusf_(float x) { return fmaxf(x, 0.f) + log1pf(__expf(-fabsf(x))); }

DEVI void conv_unit(const Params& p, const ConvJob& J, int ul, float* tile) {
  const int tid = threadIdx.x;
  const int nsub = (J.grp_w + 63) >> 6;
  const int per_k = J.ngroups * nsub;
  const int kt = ul / per_k;
  const int rem = ul - kt * per_k;
  const int g = rem / nsub, sub = rem - g * nsub;
  const int nvalid = min(64, J.grp_w - sub * 64);
  const float* src = p.in[J.in_idx] + J.src_off + g * J.grp_stride + sub * 64;
  const float* scale = (J.scale_idx >= 0) ? p.in[J.scale_idx] : nullptr;
  const int k0 = kt * 64;
  {
    const int n4 = (tid & 15) * 4, kr = tid >> 4;
#pragma unroll
    for (int i = 0; i < 4; ++i) {
      const int k = kr + 16 * i;
      float4 v = make_float4(0.f, 0.f, 0.f, 0.f);
      if (n4 < nvalid) v = *(const float4*)(src + (size_t)(k0 + k) * J.src_ld + n4);
      if (scale) { const float s = scale[k0 + k]; v.x *= s; v.y *= s; v.z *= s; v.w *= s; }
      *(float4*)(tile + k * 68 + n4) = v;
    }
  }
  __syncthreads();
  {
    const int nn = tid >> 2, ks = (tid & 3) * 16;
    if (nn < nvalid) {
      float f[16];
#pragma unroll
      for (int e = 0; e < 16; ++e) f[e] = tile[(ks + e) * 68 + nn];
      bfu* dst = (bfu*)(p.ws + OFF_W) + J.dst_off + (size_t)(g * J.grp_w + sub * 64 + nn) * J.K + k0 + ks;
      *(uint4*)dst = pack8(f);
      *(uint4*)(dst + 8) = pack8(f + 8);
    }
  }
  __syncthreads();
}

DEVI int job_units(const ConvJob& J) { return (J.K >> 6) * J.ngroups * ((J.grp_w + 63) >> 6); }

DEVI int conv_total_units(int layer) {
  int tot = 0;
  for (int j = g_job_lo[layer]; j < g_job_lo[layer + 1]; ++j) tot += job_units(g_jobs[j]);
  return tot;
}
DEVI void conv_do(const Params& p, int layer, int u, float* tile) {
  int j = g_job_lo[layer];
  for (;; ++j) {
    int n = job_units(g_jobs[j]);
    if (u < n) break;
    u -= n;
  }
  conv_unit(p, g_jobs[j], u, tile);
}

DEVI void norm_one(const Params& p, int layer, int which, int row, float4 (&x)[4], bool skip_ctx, int fix_layer, int fix_chunk) {
  const int lane = threadIdx.x & 63;
  const int b = row / TT, j = row - b * TT;
  if (skip_ctx && j < CL) return;
  const int midx = (j < CL) ? 8 : b;
  const float* xr = (const float*)(p.ws + OFF_XR) + (size_t)row * D;
  const float* mod = (const float*)(p.ws + OFF_MOD) + ((size_t)layer * 9 + midx) * 6144;
  const float* shift = mod + (which ? 3 : 0) * 1024;
  const float* scl = mod + (which ? 4 : 1) * 1024;
  const int nidx[4][2] = {{6, 11}, {16, 33}, {38, 45}, {50, 57}};
  const float* gn = p.in[nidx[layer][which]];
  float ss = 0.f;
  if (fix_layer >= 0) {
    const int mt = row >> 7, xg = mt / 18, ml = mt - xg * 18;
    if (ml >= 16) {
      const int lrow = (xg * 2 + (ml - 16)) * 128 + (row & 127);
      const float* P = (const float*)(p.ws + OFF_EX) + (size_t)lrow * D;
      const float* gate = (const float*)(p.ws + OFF_MOD) + ((size_t)fix_layer * 9 + midx) * 6144 + fix_chunk * 1024;
      float* xw = (float*)(p.ws + OFF_XR) + (size_t)row * D;
#pragma unroll
      for (int i = 0; i < 4; ++i) {
        const int c = (i * 64 + lane) * 4;
        float4 s = *(const float4*)(P + c);
#pragma unroll
        for (int q = 1; q < 4; ++q) {
          const float4 t = *(const float4*)(P + (size_t)q * 2048 * D + c);
          s.x += t.x; s.y += t.y; s.z += t.z; s.w += t.w;
        }
        const float4 g = *(const float4*)(gate + c);
        x[i].x += g.x * s.x; x[i].y += g.y * s.y; x[i].z += g.z * s.z; x[i].w += g.w * s.w;
        *(float4*)(xw + c) = x[i];
      }
    }
  }
#pragma unroll
  for (int i = 0; i < 4; ++i) ss += x[i].x * x[i].x + x[i].y * x[i].y + x[i].z * x[i].z + x[i].w * x[i].w;
  ss = wave_sum(ss);
  const float rinv = rsqrtf(ss * (1.f / 1024.f) + 1e-6f);
  bfu* u = (bfu*)(p.ws + OFF_U) + (size_t)row * D;
#pragma unroll
  for (int i = 0; i < 4; ++i) {
    const int c = (i * 64 + lane) * 4;
    float4 g4 = *(const float4*)(gn + c), s4 = *(const float4*)(scl + c), h4 = *(const float4*)(shift + c);
    float o0 = x[i].x * rinv * g4.x * (1.f + s4.x) + h4.x;
    float o1 = x[i].y * rinv * g4.y * (1.f + s4.y) + h4.y;
    float o2 = x[i].z * rinv * g4.z * (1.f + s4.z) + h4.z;
    float o3 = x[i].w * rinv * g4.w * (1.f + s4.w) + h4.w;
    uint2 w; w.x = pack2(o0, o1); w.y = pack2(o2, o3);
    *(uint2*)(u + c) = w;
  }
}

DEVI void norm_rows(const Params& p, int layer, int which, int item, bool skip_ctx, int fix_layer, int fix_chunk) {
  const int lane = threadIdx.x & 63, wave = threadIdx.x >> 6;
  const int rowA = item * 8 + wave, rowB = rowA + 4;
  const bool first = (layer == 0 && which == 0);
  const float* xa; const float* xb;
  if (first) {
    const int bA = rowA / TT, jA = rowA - bA * TT, bB = rowB / TT, jB = rowB - bB * TT;
    xa = (jA < CL) ? (p.in[2] + ((size_t)bA * CL + jA) * D) : (p.in[0] + ((size_t)bA * 2048 + (jA - CL)) * D);
    xb = (jB < CL) ? (p.in[2] + ((size_t)bB * CL + jB) * D) : (p.in[0] + ((size_t)bB * 2048 + (jB - CL)) * D);
  } else {
    xa = (const float*)(p.ws + OFF_XR) + (size_t)rowA * D;
    xb = (const float*)(p.ws + OFF_XR) + (size_t)rowB * D;
  }
  float4 a[4], b[4];
#pragma unroll
  for (int i = 0; i < 4; ++i) { a[i] = *(const float4*)(xa + (i * 64 + lane) * 4); b[i] = *(const float4*)(xb + (i * 64 + lane) * 4); }
  if (first) {
    float* wa = (float*)(p.ws + OFF_XR) + (size_t)rowA * D;
    float* wb = (float*)(p.ws + OFF_XR) + (size_t)rowB * D;
#pragma unroll
    for (int i = 0; i < 4; ++i) { *(float4*)(wa + (i * 64 + lane) * 4) = a[i]; *(float4*)(wb + (i * 64 + lane) * 4) = b[i]; }
  }
  norm_one(p, layer, which, rowA, a, skip_ctx, fix_layer, fix_chunk);
  norm_one(p, layer, which, rowB, b, skip_ctx, fix_layer, fix_chunk);
}

struct ALPlain {
  static constexpr bool kPlain = true;
  const bfu* A; int lda;
  DEVI uint4 operator()(int row, int k) const { return *(const uint4*)(A + (size_t)row * lda + k); }
};
struct ALMix {
  static constexpr bool kPlain = false;
  const bfu* U; const float* mu; const bfu* P;
  DEVI uint4 operator()(int row, int k) const {
    if (P) return *(const uint4*)(P + (size_t)row * D + k);
    const int j = row % TT;
    const bfu* pu = U + (size_t)row * D + k;
    uint4 c = *(const uint4*)pu;
    uint4 z = make_uint4(0, 0, 0, 0);
    uint4 pv = (j != 0 && j != CL) ? *(const uint4*)(pu - D) : z;
    uint4 nx = (j != CL - 1 && j != TT - 1) ? *(const uint4*)(pu + D) : z;
    float fc[8], fp[8], fn[8], o[8];
    unpack8(c, fc); unpack8(pv, fp); unpack8(nx, fn);
    float4 m0 = *(const float4*)(mu + k), m1 = *(const float4*)(mu + k + 4);
    const float mm[8] = {m0.x, m0.y, m0.z, m0.w, m1.x, m1.y, m1.z, m1.w};
#pragma unroll
    for (int e = 0; e < 8; ++e) o[e] = fc[e] + (0.5f * (fp[e] + fn[e]) - fc[e]) * mm[e];
    return pack8(o);
  }
};

template <class AL, class EP>
DEVI void gemm_tile(unsigned char* smem, const AL& al, const bfu* __restrict__ Bt, int ldb, int K, int row0, int col0, EP&& ep) {
  const int tid = threadIdx.x, lane = tid & 63, wave = tid >> 6;
  const int wm = wave >> 1, wn = wave & 1;
  bfu* S0 = (bfu*)smem;
  f32x4 acc[4][4];
#pragma unroll
  for (int a = 0; a < 4; ++a)
#pragma unroll
    for (int b = 0; b < 4; ++b) acc[a][b] = f32x4{0.f, 0.f, 0.f, 0.f};
  const int nk = K >> 6;
  const int dr = lane >> 3, dp = lane & 7;
  const int lr = tid >> 3, lc = tid & 7;
  const int l15 = lane & 15, g4 = lane >> 4;
  const int swz = (l15 >> 1) & 7;
  uint4 ra[4];
  auto issue = [&](int kt, int st) {
    bfu* As = S0 + st * 16384;
    bfu* Bs = As + 8192;
#pragma unroll
    for (int i = 0; i < 4; ++i) {
      const int R = wave * 32 + i * 8 + dr;
      const int c = dp ^ ((R >> 1) & 7);
      __builtin_amdgcn_global_load_lds((const unsigned*)(Bt + (size_t)(col0 + R) * ldb + kt * 64 + c * 8),
                                       (unsigned*)(Bs + (wave * 32 + i * 8) * 64 + lane * 8), 16, 0, 0);
      if constexpr (AL::kPlain)
        __builtin_amdgcn_global_load_lds((const unsigned*)(al.A + (size_t)(row0 + R) * al.lda + kt * 64 + c * 8),
                                         (unsigned*)(As + (wave * 32 + i * 8) * 64 + lane * 8), 16, 0, 0);
    }
  };
  auto aload = [&](int kt) {
    if constexpr (!AL::kPlain) {
#pragma unroll
      for (int i = 0; i < 4; ++i) ra[i] = al(row0 + lr + 32 * i, kt * 64 + lc * 8);
    }
  };
  auto awrite = [&](int st) {
    if constexpr (!AL::kPlain) {
      bfu* As = S0 + st * 16384;
#pragma unroll
      for (int i = 0; i < 4; ++i) {
        const int r = lr + 32 * i;
        *(uint4*)(As + r * 64 + ((lc ^ ((r >> 1) & 7)) * 8)) = ra[i];
      }
    }
  };
  issue(0, 0);
  aload(0);
  awrite(0);
  __syncthreads();
  for (int kt = 0; kt < nk; ++kt) {
    const int cur = kt & 1;
    const bool more = (kt + 1 < nk);
    if (more) { issue(kt + 1, cur ^ 1); aload(kt + 1); }
    const bfu* Ac = S0 + cur * 16384 + (wm * 64 + l15) * 64;
    const bfu* Bc = S0 + cur * 16384 + 8192 + (wn * 64 + l15) * 64;
#pragma unroll
    for (int ks = 0; ks < 2; ++ks) {
      const int po = ((ks * 4 + g4) ^ swz) * 8;
      bf16x8 af[4], bq[4];
#pragma unroll
      for (int i = 0; i < 4; ++i) {
        af[i] = *(const bf16x8*)(Ac + i * 16 * 64 + po);
        bq[i] = *(const bf16x8*)(Bc + i * 16 * 64 + po);
      }
      __builtin_amdgcn_s_setprio(1);
#pragma unroll
      for (int a = 0; a < 4; ++a)
#pragma unroll
        for (int b = 0; b < 4; ++b) acc[a][b] = __builtin_amdgcn_mfma_f32_16x16x32_bf16(af[a], bq[b], acc[a][b], 0, 0, 0);
      __builtin_amdgcn_s_setprio(0);
    }
    if (more) awrite(cur ^ 1);
    __syncthreads();
  }
  float* Cs = (float*)smem;
#pragma unroll
  for (int mi = 0; mi < 4; ++mi)
#pragma unroll
    for (int ni = 0; ni < 4; ++ni)
#pragma unroll
      for (int r = 0; r < 4; ++r) {
        const int row = wm * 64 + mi * 16 + 4 * g4 + r;
        const int col = wn * 64 + ni * 16 + l15;
        Cs[row * 132 + col] = acc[mi][ni][r];
      }
  __syncthreads();
#pragma unroll 1
  for (int ps = 0; ps < 4; ++ps) {
    const int idx = ps * 256 + tid;
    const int r = idx >> 3, seg = idx & 7;
    float v[16];
    const float4* src = (const float4*)(Cs + r * 132 + seg * 16);
#pragma unroll
    for (int q = 0; q < 4; ++q) {
      float4 t = src[q];
      v[4 * q] = t.x; v[4 * q + 1] = t.y; v[4 * q + 2] = t.z; v[4 * q + 3] = t.w;
    }
    ep(row0 + r, col0 + seg * 16, v);
  }
  __syncthreads();
}

DEVI int rowtile0(int mt, bool skip_ctx) {
  if (!skip_ctx) return mt * 128;
  const int b = mt >> 4, t = mt & 15;
  return b * TT + CL + t * 128;
}

template <class ALF, class EP>
DEVI void gemm_phase(unsigned char* smem, ALF&& alf, const bfu* Bt, int K, int NT, bool skip_ctx, EP&& ep) {
  const int MT = skip_ctx ? 128 : 144;
  if (gridDim.x & 7) {
    const int ntiles = MT * NT;
    for (int t = blockIdx.x; t < ntiles; t += gridDim.x) {
      const int mt = t / NT, nt = t - mt * NT;
      auto al = alf(nt);
      gemm_tile(smem, al, Bt, K, K, rowtile0(mt, skip_ctx), nt * 128, ep);
    }
    return;
  }
  const int4 xm = xmap_ref();
  const int nx = gridDim.x >> 3, xcd = xm.x, j = xm.y;
  const int mts = MT >> 3, per_xcd = mts * NT;
  for (int lt = j; lt < per_xcd; lt += nx) {
    int q = lt, ng = 0, gw = min(8, NT);
    while (q >= mts * gw) { q -= mts * gw; ++ng; gw = min(8, NT - 8 * ng); }
    const int ml = q / gw, nl = q - ml * gw;
    const int mt = xcd * mts + ml, nt = ng * 8 + nl;
    auto al = alf(nt);
    gemm_tile(smem, al, Bt, K, K, rowtile0(mt, skip_ctx), nt * 128, ep);
  }
}

template <int DX>
DEVI void attn_mfma(unsigned char* smem, const bfu* Q, bfu* O, const bfu* QX, const bfu* Kp, int ldk, const bfu* KX,
                    const bfu* Vp, int ldv, float sc) {
  constexpr int DQ = 64 + DX, KS = DQ + 8, NKS = DQ / 16;
  constexpr int KBUF = 64 * KS, VS = 68, VBUF = 64 * VS;
  bfu* Ksm = (bfu*)smem;
  bfu* Vsm = Ksm + 2 * KBUF;
  const int tid = threadIdx.x, lane = tid & 63, wave = tid >> 6, l31 = lane & 31, hh = lane >> 5;
  for (int it = blockIdx.x; it < 2304; it += gridDim.x) {
    int b, hq, kvh, qrow, nkeys;
    if (DX == 0) {
      int qb;
      if (it < 2048) { b = it >> 8; const int rem = it & 255; kvh = rem >> 6; qb = 8 + (rem & 63); }
      else { const int i2 = it - 2048; b = i2 >> 5; const int rem = i2 & 31; kvh = rem >> 3; qb = rem & 7; }
      hq = kvh * 4 + wave; qrow = b * TT + qb * 32; nkeys = (qb < 8) ? CL : TT;
    } else {
      int qb;
      if (it < 2048) { b = it >> 8; const int rem = it & 255; hq = rem >> 4; qb = 2 + (rem & 15); }
      else { const int i2 = it - 2048; b = i2 >> 5; const int rem = i2 & 31; hq = rem >> 1; qb = rem & 1; }
      kvh = hq; qrow = b * TT + qb * 128 + wave * 32; nkeys = (qb < 2) ? CL : TT;
    }
    const bfu* Kbase = Kp + (size_t)(b * TT) * ldk + kvh * 64;
    const bfu* KXbase = DX ? (KX + (size_t)(b * TT) * 32) : nullptr;
    const bfu* Vbase = Vp + (size_t)(b * TT) * ldv + kvh * 64;
    bf16x8 qf[NKS];
    {
      const bfu* qp = Q + (size_t)(qrow + l31) * D + hq * 64 + 8 * hh;
#pragma unroll
      for (int ks = 0; ks < 4; ++ks) qf[ks] = *(const bf16x8*)(qp + ks * 16);
      if (DX) {
        const bfu* qx = QX + (size_t)(qrow + l31) * 512 + hq * 32 + 8 * hh;
#pragma unroll
        for (int ks = 0; ks < DX / 16; ++ks) qf[4 + ks] = *(const bf16x8*)(qx + ks * 16);
      }
    }
    f32x16 ot[2];
#pragma unroll
    for (int e = 0; e < 16; ++e) { ot[0][e] = 0.f; ot[1][e] = 0.f; }
    float mrun = -1e30f, lrun = 0.f;
    uint4 rk0, rk1, rkx, rv0, rv1;
    const int kkey = tid >> 3, kkc = (tid & 7) * 8;
    const int xkey = tid >> 2, xkc = (tid & 3) * 8;
    const int vkp = tid & 31, vds = tid >> 5;
    auto gload = [&](int k0) {
      rk0 = *(const uint4*)(Kbase + (size_t)(k0 + kkey) * ldk + kkc);
      rk1 = *(const uint4*)(Kbase + (size_t)(k0 + kkey + 32) * ldk + kkc);
      if (DX) rkx = *(const uint4*)(KXbase + (size_t)(k0 + xkey) * 32 + xkc);
      rv0 = *(const uint4*)(Vbase + (size_t)(k0 + 2 * vkp) * ldv + vds * 8);
      rv1 = *(const uint4*)(Vbase + (size_t)(k0 + 2 * vkp + 1) * ldv + vds * 8);
    };
    auto lstore = [&](int buf) {
      bfu* kb = Ksm + buf * KBUF;
      *(uint4*)(kb + kkey * KS + kkc) = rk0;
      *(uint4*)(kb + (kkey + 32) * KS + kkc) = rk1;
      if (DX) *(uint4*)(kb + xkey * KS + 64 + xkc) = rkx;
      bfu* vb = Vsm + buf * VBUF + (vds * 8) * VS + 2 * vkp;
      *(unsigned*)(vb + 0 * VS) = (rv0.x & 0xffffu) | (rv1.x << 16);
      *(unsigned*)(vb + 1 * VS) = (rv0.x >> 16) | (rv1.x & 0xffff0000u);
      *(unsigned*)(vb + 2 * VS) = (rv0.y & 0xffffu) | (rv1.y << 16);
      *(unsigned*)(vb + 3 * VS) = (rv0.y >> 16) | (rv1.y & 0xffff0000u);
      *(unsigned*)(vb + 4 * VS) = (rv0.z & 0xffffu) | (rv1.z << 16);
      *(unsigned*)(vb + 5 * VS) = (rv0.z >> 16) | (rv1.z & 0xffff0000u);
      *(unsigned*)(vb + 6 * VS) = (rv0.w & 0xffffu) | (rv1.w << 16);
      *(unsigned*)(vb + 7 * VS) = (rv0.w >> 16) | (rv1.w & 0xffff0000u);
    };
    __syncthreads();
    gload(0);
    lstore(0);
    __syncthreads();
    const int ntile = nkeys >> 6;
    for (int kt = 0; kt < ntile; ++kt) {
      const int cur = kt & 1;
      const bool more = (kt + 1 < ntile);
      if (more) gload((kt + 1) * 64);
      __builtin_amdgcn_sched_barrier(0);
      f32x16 st[2];
#pragma unroll
      for (int e = 0; e < 16; ++e) { st[0][e] = 0.f; st[1][e] = 0.f; }
      const bfu* kb_ = Ksm + cur * KBUF + l31 * KS + 8 * hh;
#pragma unroll
      for (int kb = 0; kb < 2; ++kb)
#pragma unroll
        for (int ks = 0; ks < NKS; ++ks) {
          bf16x8 a = *(const bf16x8*)(kb_ + kb * 32 * KS + ks * 16);
          st[kb] = __builtin_amdgcn_mfma_f32_32x32x16_bf16(a, qf[ks], st[kb], 0, 0, 0);
        }
      float mx = st[0][0];
#pragma unroll
      for (int e = 0; e < 16; ++e) { mx = fmaxf(mx, st[0][e]); mx = fmaxf(mx, st[1][e]); }
      mx = fmaxf(mx, __shfl_xor(mx, 32));
      const float cand = mx * sc;
      if (__builtin_amdgcn_ballot_w64(cand > mrun + 8.f) != 0) {
        const float mnew = fmaxf(mrun, cand);
        const float alpha = __builtin_amdgcn_exp2f(mrun - mnew);
        lrun *= alpha;
#pragma unroll
        for (int e = 0; e < 16; ++e) { ot[0][e] *= alpha; ot[1][e] *= alpha; }
        mrun = mnew;
      }
      {
        const hwf2 sc2 = {sc, sc}, mn2 = {mrun, mrun};
        hwf2 ls2 = {0.f, 0.f};
#pragma unroll
        for (int e = 0; e < 16; e += 2) {
          hwf2 t0 = {st[0][e], st[0][e + 1]}, t1 = {st[1][e], st[1][e + 1]};
          t0 = t0 * sc2 - mn2; t1 = t1 * sc2 - mn2;
          t0.x = __builtin_amdgcn_exp2f(t0.x); t0.y = __builtin_amdgcn_exp2f(t0.y);
          t1.x = __builtin_amdgcn_exp2f(t1.x); t1.y = __builtin_amdgcn_exp2f(t1.y);
          st[0][e] = t0.x; st[0][e + 1] = t0.y; st[1][e] = t1.x; st[1][e + 1] = t1.y;
          ls2 += t0; ls2 += t1;
        }
        lrun += ls2.x + ls2.y;
      }
      const bfu* vb_ = Vsm + cur * VBUF + l31 * VS + 4 * hh;
#pragma unroll
      for (int kb = 0; kb < 2; ++kb)
#pragma unroll
        for (int s = 0; s < 2; ++s) {
          uint4 pb;
          pb.x = pack2(st[kb][8 * s + 0], st[kb][8 * s + 1]);
          pb.y = pack2(st[kb][8 * s + 2], st[kb][8 * s + 3]);
          pb.z = pack2(st[kb][8 * s + 4], st[kb][8 * s + 5]);
          pb.w = pack2(st[kb][8 * s + 6], st[kb][8 * s + 7]);
          const bf16x8 bfr = __builtin_bit_cast(bf16x8, pb);
#pragma unroll
          for (int db = 0; db < 2; ++db) {
            const bfu* va = vb_ + db * 32 * VS + kb * 32 + 16 * s;
            const uint2 lo = *(const uint2*)va;
            const uint2 hi = *(const uint2*)(va + 8);
            const uint4 au = make_uint4(lo.x, lo.y, hi.x, hi.y);
            ot[db] = __builtin_amdgcn_mfma_f32_32x32x16_bf16(__builtin_bit_cast(bf16x8, au), bfr, ot[db], 0, 0, 0);
          }
        }
      if (more) lstore(cur ^ 1);
      __syncthreads();
    }
    const float ltot = lrun + __shfl_xor(lrun, 32);
    const float inv = 1.f / ltot;
    bfu* op = O + (size_t)(qrow + l31) * D + hq * 64 + 4 * hh;
#pragma unroll
    for (int db = 0; db < 2; ++db)
#pragma unroll
      for (int g = 0; g < 4; ++g) {
        uint2 w;
        w.x = pack2(ot[db][4 * g] * inv, ot[db][4 * g + 1] * inv);
        w.y = pack2(ot[db][4 * g + 2] * inv, ot[db][4 * g + 3] * inv);
        *(uint2*)(op + db * 32 + 8 * g) = w;
      }
  }
}

DEVI float fast_softplus(float x) { return fmaxf(x, 0.f) + __logf(1.f + __expf(-fabsf(x))); }

typedef float f2 __attribute__((ext_vector_type(2)));
struct StepVec {
  f2 a[4], w[4], b[4], k[4], r[4];
  float v0, v1;
  DEVI void load(const float* sw, const float* sk, const float* sa, const float* sb, const float* sr, const float* sv,
                 int s, int sq, int ri) {
    const int o = s * 64 + sq * 8;
    const float4 a0 = *(const float4*)(sa + o), a1 = *(const float4*)(sa + o + 4);
    const float4 w0 = *(const float4*)(sw + o), w1 = *(const float4*)(sw + o + 4);
    const float4 b0 = *(const float4*)(sb + o), b1 = *(const float4*)(sb + o + 4);
    const float4 k0 = *(const float4*)(sk + o), k1 = *(const float4*)(sk + o + 4);
    const float4 r0 = *(const float4*)(sr + o), r1 = *(const float4*)(sr + o + 4);
    a[0] = f2{a0.x, a0.y}; a[1] = f2{a0.z, a0.w}; a[2] = f2{a1.x, a1.y}; a[3] = f2{a1.z, a1.w};
    w[0] = f2{w0.x, w0.y}; w[1] = f2{w0.z, w0.w}; w[2] = f2{w1.x, w1.y}; w[3] = f2{w1.z, w1.w};
    b[0] = f2{b0.x, b0.y}; b[1] = f2{b0.z, b0.w}; b[2] = f2{b1.x, b1.y}; b[3] = f2{b1.z, b1.w};
    k[0] = f2{k0.x, k0.y}; k[1] = f2{k0.z, k0.w}; k[2] = f2{k1.x, k1.y}; k[3] = f2{k1.z, k1.w};
    r[0] = f2{r0.x, r0.y}; r[1] = f2{r0.z, r0.w}; r[2] = f2{r1.x, r1.y}; r[3] = f2{r1.z, r1.w};
    const float2 vv = *(const float2*)(sv + s * 64 + ri);
    v0 = vv.x; v1 = vv.y;
  }
};
DEVI void rwkv_step(const StepVec& x, f2 (&S0)[4], f2 (&S1)[4], float* ydst, int sq) {
  f2 d0 = S0[0] * x.a[0], d1 = S1[0] * x.a[0];
#pragma unroll
  for (int e = 1; e < 4; ++e) { d0 += S0[e] * x.a[e]; d1 += S1[e] * x.a[e]; }
  const float dot0 = sum8(d0.x + d0.y), dot1 = sum8(d1.x + d1.y);
  const f2 dd0 = f2{dot0, dot0}, dd1 = f2{dot1, dot1};
  const f2 vv0 = f2{x.v0, x.v0}, vv1 = f2{x.v1, x.v1};
#pragma unroll
  for (int e = 0; e < 4; ++e) {
    S0[e] = S0[e] * x.w[e] + (dd0 * x.b[e] + vv0 * x.k[e]);
    S1[e] = S1[e] * x.w[e] + (dd1 * x.b[e] + vv1 * x.k[e]);
  }
  f2 y0 = S0[0] * x.r[0], y1 = S1[0] * x.r[0];
#pragma unroll
  for (int e = 1; e < 4; ++e) { y0 += S0[e] * x.r[e]; y1 += S1[e] * x.r[e]; }
  const float ys0 = sum8(y0.x + y0.y), ys1 = sum8(y1.x + y1.y);
  if (sq == 0) *(float2*)ydst = make_float2(ys0, ys1);
}

DEVI void rwkv_scan(const Params& p, unsigned char* smem) {
  float* sw = (float*)smem;
  float* sk = sw + 2048;
  float* sa = sk + 2048;
  float* sb = sa + 2048;
  float* sr = sb + 2048;
  float* sv = sr + 2048;
  float* sy = sv + 2048;
  const int tid = threadIdx.x, lane = tid & 63, wave = tid >> 6, l31 = lane & 31, hh = lane >> 5;
  const bfu* R = (const bfu*)(p.ws + OFF_BIG);
  const bfu* Kb = (const bfu*)(p.ws + OFF_BIG + SLOT);
  const bfu* Vb = (const bfu*)(p.ws + OFF_BIG + 2 * SLOT);
  const bfu* TW = (const bfu*)(p.ws + OFF_TW);
  const bfu* AA = (const bfu*)(p.ws + OFF_AA);
  const bfu* Wt = (const bfu*)(p.ws + OFF_W);
  float* BON = (float*)(p.ws + OFF_BON);
  const int qn = wave >> 1, cb = wave & 1;
  for (int it = blockIdx.x; it < 256; it += gridDim.x) {
    const int dir = it >> 7, b = (it >> 4) & 7, h = it & 15;
    bfu* Y = (bfu*)(p.ws + (dir ? OFF_EX : OFF_U));
    const int ch = h * 64 + lane;
    const float kkc = p.in[27][ch], kac = p.in[28][ch], rkc = p.in[29][ch];
    const int chm = h * 64 + cb * 32 + l31;
    const float bias_m = qn ? p.in[22][dir * 1024 + chm] : p.in[19][dir * 1024 + chm];
    bf16x8 bfr[4];
    {
      const bfu* wp = Wt + (qn ? A2T : W2T) + dir * 65536 + (size_t)chm * 64 + 8 * hh;
#pragma unroll
      for (int ks = 0; ks < 4; ++ks) bfr[ks] = *(const bf16x8*)(wp + ks * 16);
    }
    const bfu* LA = qn ? AA : TW;
    const int sq = lane & 7, ri = wave * 16 + (lane >> 3) * 2;
    f2 S0[4], S1[4];
#pragma unroll
    for (int e = 0; e < 4; ++e) { S0[e] = f2{0.f, 0.f}; S1[e] = f2{0.f, 0.f}; }
    bf16x8 afr[4];
    unsigned short pk_[8], pv_[8], pr_[8];
    auto tokbase = [&](int c, int& jbase, int& jstep) {
      const int p0 = c * 32;
      jbase = dir ? ((p0 < CL) ? (CL - 1 - p0) : (TT + CL - 1 - p0)) : p0;
      jstep = dir ? -1 : 1;
    };
    auto prefetch = [&](int c) {
      int jbase, jstep;
      tokbase(c, jbase, jstep);
      {
        const size_t row = (size_t)b * TT + (jbase + jstep * l31);
        const bfu* ap = LA + row * 128 + dir * 64 + 8 * hh;
#pragma unroll
        for (int ks = 0; ks < 4; ++ks) afr[ks] = *(const bf16x8*)(ap + ks * 16);
      }
#pragma unroll
      for (int i = 0; i < 8; ++i) {
        const int s = wave + 4 * i;
        const size_t off = ((size_t)b * TT + (jbase + jstep * s)) * D + ch;
        pk_[i] = Kb[off]; pv_[i] = Vb[off]; pr_[i] = R[off];
      }
    };
    __syncthreads();
    prefetch(0);
    for (int c = 0; c < 72; ++c) {
      int jbase, jstep;
      tokbase(c, jbase, jstep);
      {
        f32x16 acc;
#pragma unroll
        for (int e = 0; e < 16; ++e) acc[e] = 0.f;
#pragma unroll
        for (int ks = 0; ks < 4; ++ks) acc = __builtin_amdgcn_mfma_f32_32x32x16_bf16(afr[ks], bfr[ks], acc, 0, 0, 0);
        float* dst = (qn ? sb : sw) + cb * 32 + l31;
#pragma unroll
        for (int r = 0; r < 16; ++r) {
          const int step = (r & 3) + 8 * (r >> 2) + 4 * hh;
          const float x = acc[r] + bias_m;
          float o;
          if (qn) o = 1.f / (1.f + __expf(-x));
          else o = __expf(-0.60653066f / (1.f + __expf(-x)));
          dst[step * 64] = o;
        }
      }
      __syncthreads();
#pragma unroll
      for (int i = 0; i < 8; ++i) {
        const int s = wave + 4 * i;
        const float av = sb[s * 64 + lane];
        const float kv = bf2f(pk_[i]), vv = bf2f(pv_[i]), rv = bf2f(pr_[i]);
        const float kdir = kv * (1.f + (av - 1.f) * kac);
        const float kkraw = kv * kkc;
        const float kk = kkraw * rsqrtf(fmaxf(wave_sum(kkraw * kkraw), 1e-24f));
        const float bon = wave_sum(rv * kdir * rkc);
        if (lane == 0) BON[((size_t)dir * M + (size_t)b * TT + (jbase + jstep * s)) * 16 + h] = bon;
        sk[s * 64 + lane] = kdir;
        sa[s * 64 + lane] = -kk;
        sb[s * 64 + lane] = kk * av;
        sr[s * 64 + lane] = rv;
        sv[s * 64 + lane] = vv;
      }
      __syncthreads();
      if (c + 1 < 72) prefetch(c + 1);
      StepVec va, vb;
      va.load(sw, sk, sa, sb, sr, sv, 0, sq, ri);
#pragma unroll 1
      for (int s = 0; s < 32; s += 2) {
        vb.load(sw, sk, sa, sb, sr, sv, s + 1, sq, ri);
        rwkv_step(va, S0, S1, sy + s * 64 + ri, sq);
        if (s + 2 < 32) va.load(sw, sk, sa, sb, sr, sv, s + 2, sq, ri);
        rwkv_step(vb, S0, S1, sy + (s + 1) * 64 + ri, sq);
      }
      __syncthreads();
      {
        const int s = tid >> 3, sg = tid & 7;
        const size_t row = (size_t)b * TT + (jbase + jstep * s);
        float f[8];
#pragma unroll
        for (int e = 0; e < 8; ++e) f[e] = sy[s * 64 + sg * 8 + e];
        *(uint4*)(Y + row * D + h * 64 + sg * 8) = pack8(f);
      }
    }
    __syncthreads();
  }
}

DEVI void rwkv_post(const Params& p) {
  const bfu* Y0 = (const bfu*)(p.ws + OFF_U);
  const bfu* Y1 = (const bfu*)(p.ws + OFF_EX);
  const bfu* Vb = (const bfu*)(p.ws + OFF_BIG + 2 * SLOT);
  const bfu* G = (const bfu*)(p.ws + OFF_BIG + 3 * SLOT);
  const float* BON = (const float*)(p.ws + OFF_BON);
  bfu* A = (bfu*)(p.ws + OFF_BIG);
  const float* lnw = p.in[30];
  const float* lnb = p.in[31];
  const int total = M * 64;
  for (int idx = blockIdx.x * NTHR + threadIdx.x; idx < total; idx += gridDim.x * NTHR) {
    const int row = idx >> 6, rem = idx & 63;
    const int h = rem >> 2, sg = rem & 3;
    const size_t off = (size_t)row * D + h * 64 + sg * 16;
    float y[16], t[16];
    unpack8(*(const uint4*)(Y0 + off), y); unpack8(*(const uint4*)(Y0 + off + 8), y + 8);
    unpack8(*(const uint4*)(Y1 + off), t); unpack8(*(const uint4*)(Y1 + off + 8), t + 8);
    float s = 0.f;
#pragma unroll
    for (int e = 0; e < 16; ++e) { y[e] += t[e]; s += y[e]; }
    s = sum4(s);
    const float mean = s * (1.f / 64.f);
    float vs = 0.f;
#pragma unroll
    for (int e = 0; e < 16; ++e) { const float d = y[e] - mean; vs += d * d; }
    vs = sum4(vs);
    const float rinv = rsqrtf(vs * (1.f / 64.f) + 64e-5f);
    const float bon = BON[(size_t)row * 16 + h] + BON[((size_t)M + row) * 16 + h];
    float vv[16], gg[16], o[16];
    unpack8(*(const uint4*)(Vb + off), vv); unpack8(*(const uint4*)(Vb + off + 8), vv + 8);
    unpack8(*(const uint4*)(G + off), gg); unpack8(*(const uint4*)(G + off + 8), gg + 8);
    const int c0 = h * 64 + sg * 16;
#pragma unroll
    for (int e = 0; e < 16; ++e) {
      const float yn = (y[e] - mean) * rinv * lnw[c0 + e] + lnb[c0 + e] + bon * vv[e];
      o[e] = yn * gg[e];
    }
    store16bf(A + off, o);
  }
}

DEVI void gla_scan(const Params& p, unsigned char* smem) {
  constexpr int QS = 136, TS = 72;
  bfu* Ql = (bfu*)smem;
  bfu* Kl = Ql + 64 * QS;
  bfu* KeT = Kl + 64 * QS;
  bfu* Vt = KeT + 128 * TS;
  bfu* Att = Vt + 64 * TS;
  float* sgd = (float*)Att;
  float* tot = (float*)(Att + 64 * TS);
  float* ebl = tot + 512;
  const int tid = threadIdx.x, lane = tid & 63, wave = tid >> 6, l15 = lane & 15, g4 = lane >> 4;
  const bfu* GQ = (const bfu*)(p.ws + OFF_BIG);
  const bfu* GK = GQ + (size_t)M * 512;
  const bfu* GV = (const bfu*)(p.ws + OFF_BIG + SLOT);
  const float* GD = (const float*)(p.ws + OFF_GD);
  const float* gup = p.in[53];
  const float* gbias = p.in[54];
  for (int it = blockIdx.x; it < 256; it += gridDim.x) {
    const int dir = it >> 7, b = (it >> 4) & 7, h = (it >> 2) & 3, vs = it & 3;
    bfu* O = (bfu*)(p.ws + (dir ? OFF_EX : OFF_BIG + 3 * SLOT));
    const int kp = lane;
    float gu0[16], gu1[16];
#pragma unroll
    for (int r = 0; r < 16; ++r) {
      const float2 t = *(const float2*)(gup + (dir * 16 + r) * 512 + h * 128 + 2 * kp);
      gu0[r] = t.x; gu1[r] = t.y;
    }
    const float2 gbv = *(const float2*)(gbias + dir * 512 + h * 128 + 2 * kp);
    f32x4 S[8];
#pragma unroll
    for (int i = 0; i < 8; ++i) S[i] = f32x4{0.f, 0.f, 0.f, 0.f};
    uint4 pq0, pq1, pq2, pq3, pk0, pk1, pk2, pk3, pv0, pv1;
    float4 pgd;
    auto tokbase = [&](int c, int& jbase, int& jstep) {
      const int p0 = c * 64;
      jbase = dir ? ((p0 < CL) ? (CL - 1 - p0) : (TT + CL - 1 - p0)) : p0;
      jstep = dir ? -1 : 1;
    };
    const int ls = tid >> 4, lkc = (tid & 15) * 8;
    const int vsp = tid & 31, vseg = tid >> 5;
#define GLA_PREFETCH(CC) do { \
      int jb_, js_; tokbase((CC), jb_, js_); \
      const size_t ra_ = (size_t)b * TT + (jb_ + js_ * (ls)); \
      const size_t rb_ = (size_t)b * TT + (jb_ + js_ * (ls + 16)); \
      const size_t rc_ = (size_t)b * TT + (jb_ + js_ * (ls + 32)); \
      const size_t rd_ = (size_t)b * TT + (jb_ + js_ * (ls + 48)); \
      pq0 = *(const uint4*)(GQ + ra_ * 512 + h * 128 + lkc); pk0 = *(const uint4*)(GK + ra_ * 512 + h * 128 + lkc); \
      pq1 = *(const uint4*)(GQ + rb_ * 512 + h * 128 + lkc); pk1 = *(const uint4*)(GK + rb_ * 512 + h * 128 + lkc); \
      pq2 = *(const uint4*)(GQ + rc_ * 512 + h * 128 + lkc); pk2 = *(const uint4*)(GK + rc_ * 512 + h * 128 + lkc); \
      pq3 = *(const uint4*)(GQ + rd_ * 512 + h * 128 + lkc); pk3 = *(const uint4*)(GK + rd_ * 512 + h * 128 + lkc); \
      const size_t r0_ = (size_t)b * TT + (jb_ + js_ * (2 * vsp)); \
      const size_t r1_ = (size_t)b * TT + (jb_ + js_ * (2 * vsp + 1)); \
      pv0 = *(const uint4*)(GV + r0_ * D + h * 256 + vs * 64 + vseg * 8); \
      pv1 = *(const uint4*)(GV + r1_ * D + h * 256 + vs * 64 + vseg * 8); \
      const size_t rg_ = (size_t)b * TT + (jb_ + js_ * (tid >> 2)); \
      pgd = *(const float4*)(GD + rg_ * 32 + dir * 16 + (tid & 3) * 4); \
    } while (0)
    __syncthreads();
    GLA_PREFETCH(0);
    for (int c = 0; c < 36; ++c) {
      int jbase, jstep;
      tokbase(c, jbase, jstep);
      *(uint4*)(Ql + (ls) * QS + lkc) = pq0; *(uint4*)(Kl + (ls) * QS + lkc) = pk0;
      *(uint4*)(Ql + (ls + 16) * QS + lkc) = pq1; *(uint4*)(Kl + (ls + 16) * QS + lkc) = pk1;
      *(uint4*)(Ql + (ls + 32) * QS + lkc) = pq2; *(uint4*)(Kl + (ls + 32) * QS + lkc) = pk2;
      *(uint4*)(Ql + (ls + 48) * QS + lkc) = pq3; *(uint4*)(Kl + (ls + 48) * QS + lkc) = pk3;
      {
        bfu* vb = Vt + (vseg * 8) * TS + 2 * vsp;
        *(unsigned*)(vb + 0 * TS) = (pv0.x & 0xffffu) | (pv1.x << 16);
        *(unsigned*)(vb + 1 * TS) = (pv0.x >> 16) | (pv1.x & 0xffff0000u);
        *(unsigned*)(vb + 2 * TS) = (pv0.y & 0xffffu) | (pv1.y << 16);
        *(unsigned*)(vb + 3 * TS) = (pv0.y >> 16) | (pv1.y & 0xffff0000u);
        *(unsigned*)(vb + 4 * TS) = (pv0.z & 0xffffu) | (pv1.z << 16);
        *(unsigned*)(vb + 5 * TS) = (pv0.z >> 16) | (pv1.z & 0xffff0000u);
        *(unsigned*)(vb + 6 * TS) = (pv0.w & 0xffffu) | (pv1.w << 16);
        *(unsigned*)(vb + 7 * TS) = (pv0.w >> 16) | (pv1.w & 0xffff0000u);
        *(float4*)(sgd + (tid >> 2) * 16 + (tid & 3) * 4) = pgd;
      }
      __syncthreads();
      if (c + 1 < 36) GLA_PREFETCH(c + 1);
      float al0[16], al1[16];
      float pr0 = 1.f, pr1 = 1.f;
#pragma unroll
      for (int i = 0; i < 16; ++i) {
        const float4* gd = (const float4*)(sgd + (wave * 16 + i) * 16);
        float x0 = gbv.x, x1 = gbv.y;
#pragma unroll
        for (int q4 = 0; q4 < 4; ++q4) {
          const float4 t = gd[q4];
          x0 += t.x * gu0[4 * q4] + t.y * gu0[4 * q4 + 1] + t.z * gu0[4 * q4 + 2] + t.w * gu0[4 * q4 + 3];
          x1 += t.x * gu1[4 * q4] + t.y * gu1[4 * q4 + 1] + t.z * gu1[4 * q4 + 2] + t.w * gu1[4 * q4 + 3];
        }
        al0[i] = __expf(-fast_softplus(-x0) * (1.f / 16.f));
        al1[i] = __expf(-fast_softplus(-x1) * (1.f / 16.f));
        pr0 *= al0[i]; pr1 *= al1[i];
      }
      *(float2*)(tot + wave * 128 + 2 * kp) = make_float2(pr0, pr1);
      __syncthreads();
      {
        float c0 = 1.f, c1 = 1.f, e0 = 1.f, e1 = 1.f;
#pragma unroll
        for (int w = 0; w < 4; ++w) {
          const float2 t = *(const float2*)(tot + w * 128 + 2 * kp);
          if (w < wave) { c0 *= t.x; c1 *= t.y; }
          e0 *= t.x; e1 *= t.y;
        }
        if (wave == 0) *(float2*)(ebl + 2 * kp) = make_float2(e0, e1);
        unsigned* d0 = (unsigned*)(KeT + (2 * kp) * TS + wave * 16);
        unsigned* d1 = (unsigned*)(KeT + (2 * kp + 1) * TS + wave * 16);
#pragma unroll
        for (int j = 0; j < 8; ++j) {
          unsigned short ka[2], kb2[2];
#pragma unroll
          for (int u = 0; u < 2; ++u) {
            const int i = 2 * j + u;
            const int s = wave * 16 + i;
            c0 *= al0[i]; c1 *= al1[i];
            const float i0 = __builtin_amdgcn_rcpf(c0), i1 = __builtin_amdgcn_rcpf(c1);
            unsigned* qp = (unsigned*)(Ql + s * QS + 2 * kp);
            unsigned* kq = (unsigned*)(Kl + s * QS + 2 * kp);
            const unsigned qw = *qp, kw = *kq;
            *qp = pack2(bflo(qw) * c0, bfhi(qw) * c1);
            const float k0 = bflo(kw), k1 = bfhi(kw);
            *kq = pack2(k0 * i0, k1 * i1);
            ka[u] = f2bf(k0 * (e0 * i0)); kb2[u] = f2bf(k1 * (e1 * i1));
          }
          d0[j] = (unsigned)ka[0] | ((unsigned)ka[1] << 16);
          d1[j] = (unsigned)kb2[0] | ((unsigned)kb2[1] << 16);
        }
      }
      __syncthreads();
      const bool want_o = (c >= 4);
      if (want_o) {
        f32x4 at[4];
#pragma unroll
        for (int sb = 0; sb < 4; ++sb) at[sb] = f32x4{0.f, 0.f, 0.f, 0.f};
#pragma unroll
        for (int ks = 0; ks < 4; ++ks) {
          const bf16x8 a = *(const bf16x8*)(Ql + (wave * 16 + l15) * QS + ks * 32 + g4 * 8);
#pragma unroll
          for (int sb = 0; sb < 4; ++sb) {
            const bf16x8 bb = *(const bf16x8*)(Kl + (sb * 16 + l15) * QS + ks * 32 + g4 * 8);
            at[sb] = __builtin_amdgcn_mfma_f32_16x16x32_bf16(a, bb, at[sb], 0, 0, 0);
          }
        }
#pragma unroll
        for (int sb = 0; sb < 4; ++sb)
#pragma unroll
          for (int r = 0; r < 4; ++r) {
            const int t = wave * 16 + g4 * 4 + r, s = sb * 16 + l15;
            Att[t * TS + s] = f2bf((s <= t) ? at[sb][r] : 0.f);
          }
      }
      __syncthreads();
      {
        bf16x8 sf[4];
#pragma unroll
        for (int ks = 0; ks < 4; ++ks) {
          uint4 u;
          u.x = pack2(S[2 * ks][0], S[2 * ks][1]); u.y = pack2(S[2 * ks][2], S[2 * ks][3]);
          u.z = pack2(S[2 * ks + 1][0], S[2 * ks + 1][1]); u.w = pack2(S[2 * ks + 1][2], S[2 * ks + 1][3]);
          sf[ks] = __builtin_bit_cast(bf16x8, u);
        }
        bf16x8 vf[2];
#pragma unroll
        for (int k2 = 0; k2 < 2; ++k2) vf[k2] = *(const bf16x8*)(Vt + (wave * 16 + l15) * TS + k2 * 32 + g4 * 8);
        if (want_o)
#pragma unroll
        for (int tb = 0; tb < 4; ++tb) {
          f32x4 o = f32x4{0.f, 0.f, 0.f, 0.f};
#pragma unroll
          for (int ks = 0; ks < 4; ++ks) {
            const bfu* qa = Ql + (tb * 16 + l15) * QS + ks * 32 + g4 * 4;
            const uint2 lo = *(const uint2*)qa;
            const uint2 hi = *(const uint2*)(qa + 16);
            const uint4 au = make_uint4(lo.x, lo.y, hi.x, hi.y);
            o = __builtin_amdgcn_mfma_f32_16x16x32_bf16(__builtin_bit_cast(bf16x8, au), sf[ks], o, 0, 0, 0);
          }
#pragma unroll
          for (int k2 = 0; k2 < 2; ++k2) {
            const bf16x8 a = *(const bf16x8*)(Att + (tb * 16 + l15) * TS + k2 * 32 + g4 * 8);
            o = __builtin_amdgcn_mfma_f32_16x16x32_bf16(a, vf[k2], o, 0, 0, 0);
          }
#pragma unroll
          for (int r = 0; r < 4; ++r) {
            const int t = tb * 16 + g4 * 4 + r;
            const size_t row = (size_t)b * TT + (jbase + jstep * t);
            O[row * D + h * 256 + vs * 64 + wave * 16 + l15] = f2bf(o[r]);
          }
        }
#pragma unroll
        for (int kb = 0; kb < 8; ++kb) {
          const float4 e = *(const float4*)(ebl + kb * 16 + g4 * 4);
          S[kb][0] *= e.x; S[kb][1] *= e.y; S[kb][2] *= e.z; S[kb][3] *= e.w;
#pragma unroll
          for (int k2 = 0; k2 < 2; ++k2) {
            const bf16x8 a = *(const bf16x8*)(KeT + (kb * 16 + l15) * TS + k2 * 32 + g4 * 8);
            S[kb] = __builtin_amdgcn_mfma_f32_16x16x32_bf16(a, vf[k2], S[kb], 0, 0, 0);
          }
        }
      }
      __syncthreads();
    }
  }
}

DEVI void gla_post(const Params& p) {
  const bfu* O0 = (const bfu*)(p.ws + OFF_BIG + 3 * SLOT);
  const bfu* O1 = (const bfu*)(p.ws + OFF_EX);
  const bfu* GO = (const bfu*)(p.ws + OFF_BIG + 2 * SLOT);
  bfu* A = (bfu*)(p.ws + OFF_BIG);
  const float* og = p.in[55];
  const int total = M * 64;
  for (int idx = blockIdx.x * NTHR + threadIdx.x; idx < total; idx += gridDim.x * NTHR) {
    const int row = idx >> 6, rem = idx & 63;
    if (row % TT < CL) continue;
    const int h = rem >> 4, sg = rem & 15;
    const size_t off = (size_t)row * D + h * 256 + sg * 16;
    float y[16], t[16];
    unpack8(*(const uint4*)(O0 + off), y); unpack8(*(const uint4*)(O0 + off + 8), y + 8);
    unpack8(*(const uint4*)(O1 + off), t); unpack8(*(const uint4*)(O1 + off + 8), t + 8);
    float s = 0.f;
#pragma unroll
    for (int e = 0; e < 16; ++e) { y[e] += t[e]; s += y[e] * y[e]; }
    s = sum16(s);
    const float rinv = rsqrtf(s * (1.f / 256.f) + 1e-6f);
    float gg[16], o[16];
    unpack8(*(const uint4*)(GO + off), gg); unpack8(*(const uint4*)(GO + off + 8), gg + 8);
#pragma unroll
    for (int e = 0; e < 16; ++e) {
      const float g = gg[e];
      o[e] = y[e] * rinv * og[sg * 16 + e] * (g * sigmoidf_(g));
    }
    store16bf(A + off, o);
  }
}

DEVI void init_phase(const Params& p, unsigned char* smem) {
  const int tid = threadIdx.x;
  const int nconv = conv_total_units(0);
  const int n_mod = 384, n_copy = 0, n_rope = 384;
  const int total = n_mod + nconv + n_copy + n_rope;
  float* fs = (float*)smem;
  for (int it = blockIdx.x; it < total; it += gridDim.x) {
    if (it < n_mod) {
      const int l = it / 96, n = (it - l * 96) * 64 + (tid & 63);
      const int wv = tid >> 6;
      __syncthreads();
      for (int i = tid; i < 9 * 1024; i += NTHR) {
        const int m = i >> 10, k = i & 1023;
        const float c = (m < 8) ? p.in[1][m * 1024 + k] : p.in[3][k];
        fs[i] = c / (1.f + __expf(-c));
      }
      __syncthreads();
      const float* aw = p.in[4 + (l == 0 ? 0 : l == 1 ? 10 : l == 2 ? 32 : 44)];
      const float* ab = p.in[5 + (l == 0 ? 0 : l == 1 ? 10 : l == 2 ? 32 : 44)];
      float acc[9];
#pragma unroll
      for (int m = 0; m < 9; ++m) acc[m] = 0.f;
      for (int k = wv * 256; k < wv * 256 + 256; k += 4) {
        const float w0 = aw[(size_t)k * 6144 + n], w1 = aw[(size_t)(k + 1) * 6144 + n];
        const float w2 = aw[(size_t)(k + 2) * 6144 + n], w3 = aw[(size_t)(k + 3) * 6144 + n];
#pragma unroll
        for (int m = 0; m < 9; ++m) {
          const float4 s = *(const float4*)(fs + m * 1024 + k);
          acc[m] += s.x * w0 + s.y * w1 + s.z * w2 + s.w * w3;
        }
      }
      float* red = fs + 9 * 1024;
#pragma unroll
      for (int m = 0; m < 9; ++m) red[(wv * 9 + m) * 64 + (tid & 63)] = acc[m];
      __syncthreads();
      if (wv == 0) {
        float* mod = (float*)(p.ws + OFF_MOD) + (size_t)l * 9 * 6144;
        const float bias = ab[n];
#pragma unroll
        for (int m = 0; m < 9; ++m)
          mod[m * 6144 + n] = red[m * 64 + tid] + red[(9 + m) * 64 + tid] + red[(18 + m) * 64 + tid] + red[(27 + m) * 64 + tid] + bias;
      }
      __syncthreads();
    } else if (it < n_mod + nconv) {
      conv_do(p, 0, it - n_mod, fs);
    } else if (it < n_mod + nconv + n_copy) {
      const int r0 = (it - n_mod - nconv) * 8;
      float* xr = (float*)(p.ws + OFF_XR);
#pragma unroll
      for (int i = 0; i < 8; ++i) {
        const int row = r0 + i;
        const int b = row / TT, j = row - b * TT;
        const float* src = (j < CL) ? (p.in[2] + ((size_t)b * CL + j) * D) : (p.in[0] + ((size_t)b * 2048 + (j - CL)) * D);
        *(float4*)(xr + (size_t)row * D + tid * 4) = *(const float4*)(src + tid * 4);
      }
    } else {
      const int e = (it - n_mod - nconv - n_copy) * 256 + tid;
      if (e < 2048 * 32) {
        const int t = e >> 5, i = e & 31;
        const int f = i & 15;
        const float inv = powf(10000.f, -(float)f / 16.f);
        const float pos = (i < 16) ? (float)(t >> 6) : (float)(t & 63);
        const float ang = pos * inv;
        float* ra = (float*)(p.ws + OFF_ROPEA);
        ra[e] = cosf(ang);
        ra[2048 * 32 + e] = sinf(ang);
      } else {
        const int e2 = e - 2048 * 32;
        const int t = e2 >> 4, i = e2 & 15;
        const int f = i & 7;
        const float inv = powf(10000.f, -(float)f / 8.f);
        const float pos = (i < 8) ? (float)(t >> 6) : (float)(t & 63);
        const float ang = pos * inv;
        float* rc = (float*)(p.ws + OFF_ROPEC);
        rc[e2] = cosf(ang);
        rc[2048 * 16 + e2] = sinf(ang);
      }
    }
  }
}

DEVI void norm_phase(const Params& p, unsigned char* smem, int layer, int which, int conv_layer, bool skip_ctx,
                     int fix_layer = -1, int fix_chunk = 0) {
  const int nconv = (conv_layer >= 0) ? conv_total_units(conv_layer) : 0;
  const int total = nconv + M / 8;
  if (gridDim.x != 512) fix_layer = -1;
  for (int it = blockIdx.x; it < total; it += gridDim.x) {
    if (it < nconv) conv_do(p, conv_layer, it, (float*)smem);
    else norm_rows(p, layer, which, it - nconv, skip_ctx, fix_layer, fix_chunk);
  }
}

struct EpiPartial {
  float* P; int q;
  DEVI void operator()(int row, int col, float (&v)[16]) const {
    const int mt = row >> 7, x = mt / 18, ml = mt - x * 18;
    const int lrow = (x * 2 + (ml - 16)) * 128 + (row & 127);
    float* d = P + ((size_t)q * 2048 + lrow) * D + col;
#pragma unroll
    for (int i = 0; i < 4; ++i) *(float4*)(d + 4 * i) = make_float4(v[4 * i], v[4 * i + 1], v[4 * i + 2], v[4 * i + 3]);
  }
};
struct EpiRes {
  float* xr; const float* mod; int chunk;
  DEVI void operator()(int row, int col, float (&v)[16]) const {
    const int b = row / TT, j = row - b * TT;
    const int midx = (j < CL) ? 8 : b;
    const float* g = mod + (size_t)midx * 6144 + chunk * 1024 + col;
    float* x = xr + (size_t)row * D + col;
#pragma unroll
    for (int q = 0; q < 4; ++q) {
      float4 xv = *(float4*)(x + 4 * q);
      const float4 gv = *(const float4*)(g + 4 * q);
      xv.x += gv.x * v[4 * q]; xv.y += gv.y * v[4 * q + 1]; xv.z += gv.z * v[4 * q + 2]; xv.w += gv.w * v[4 * q + 3];
      *(float4*)(x + 4 * q) = xv;
    }
  }
};

DEVI void res_gemm_phase(const Params& p, unsigned char* smem, int layer, int chunk, const bfu* A, int K, const bfu* W, bool skip_ctx) {
  float* xr = (float*)(p.ws + OFF_XR);
  const float* mod = (const float*)(p.ws + OFF_MOD) + (size_t)layer * 9 * 6144;
  EpiRes ep{xr, mod, chunk};
  if (skip_ctx || gridDim.x != 512) {
    gemm_phase(smem, [&](int) { return ALPlain{A, K}; }, W, K, 8, skip_ctx, ep);
    return;
  }
  const int4 xm = xmap_ref();
  const int xcd = xm.x, j = xm.y;
  for (int lt = j; lt < 128; lt += 64) {
    const int mt = xcd * 18 + (lt >> 3), nt = lt & 7;
    gemm_tile(smem, ALPlain{A, K}, W, K, K, mt * 128, nt * 128, ep);
  }
  {
    const int lt = 128 + (j >> 2), kq = j & 3, kl = K >> 2;
    EpiPartial epa{(float*)(p.ws + OFF_EX), kq};
    const int mt = xcd * 18 + (lt >> 3), nt = lt & 7;
    gemm_tile(smem, ALPlain{A + kq * kl, K}, W + kq * kl, K, kl, mt * 128, nt * 128, epa);
  }
}

DEVI void mlp_up_phase(const Params& p, unsigned char* smem, bool skip_ctx) {
  const bfu* U = (const bfu*)(p.ws + OFF_U);
  const bfu* W = (const bfu*)(p.ws + OFF_W) + WUP;
  bfu* H = (bfu*)(p.ws + OFF_BIG);
  gemm_phase(smem, [&](int) { return ALPlain{U, D}; }, W, 1024, 32, skip_ctx,
             [&](int row, int col, float (&v)[16]) {
#pragma unroll
               for (int e = 0; e < 16; ++e) { const float r = fmaxf(v[e], 0.f); v[e] = r * r; }
               store16bf(H + (size_t)row * 4096 + col, v);
             });
}
DEVI void mlp_down_phase(const Params& p, unsigned char* smem, int layer, bool skip_ctx) {
  res_gemm_phase(p, smem, layer, 5, (const bfu*)(p.ws + OFF_BIG), 4096, (const bfu*)(p.ws + OFF_W) + WDN, skip_ctx);
}
DEVI void out_phase(const Params& p, unsigned char* smem, int layer, const bfu* A, int woff, bool skip_ctx) {
  res_gemm_phase(p, smem, layer, 2, A, 1024, (const bfu*)(p.ws + OFF_W) + woff, skip_ctx);
}

#define PROBE_DUP(PH) 0
enum {
  PH_INIT = 0,
  PH_L0_NORM1, PH_L0_IN, PH_L0_ATT, PH_L0_OUT, PH_L0_NORM2, PH_L0_UP, PH_L0_DOWN,
  PH_L1_NORM1, PH_L1_MIX, PH_L1_IN, PH_L1_G, PH_L1_SCAN, PH_L1_POST, PH_L1_OUT, PH_L1_NORM2, PH_L1_UP, PH_L1_DOWN,
  PH_L2_NORM1, PH_L2_IN, PH_L2_QKV, PH_L2_ATT, PH_L2_OUT, PH_L2_NORM2, PH_L2_UP, PH_L2_DOWN,
  PH_L3_NORM1, PH_L3_IN, PH_L3_SCAN, PH_L3_POST, PH_L3_OUT, PH_L3_NORM2, PH_L3_UP, PH_L3_DOWN,
  PH_FINAL, NPHASES
};

template <int ph>
__device__ __forceinline__ void run_phase(const Params& p, unsigned char* smem) {
  const bfu* U = (const bfu*)(p.ws + OFF_U);
  const bfu* Wt = (const bfu*)(p.ws + OFF_W);
  unsigned char* big = p.ws + OFF_BIG;
  switch (ph) {
    case PH_INIT: init_phase(p, smem); break;
    case PH_L0_NORM1: norm_phase(p, smem, 0, 0, -1, false); break;
    case PH_L0_IN: {
      bfu* Q = (bfu*)big; bfu* Kb = (bfu*)(big + SLOT); bfu* Vb = Kb + (size_t)M * 256;
      const float* qg = p.in[8]; const float* kg = p.in[9];
      const float* cosA = (const float*)(p.ws + OFF_ROPEA); const float* sinA = cosA + 2048 * 32;
      gemm_phase(smem, [&](int) { return ALPlain{U, D}; }, Wt + WIN0, 1024, 12, false,
                 [&](int row, int col, float (&v)[16]) {
                   const int b = row / TT, j = row - b * TT;
                   if (col < 1280) {
                     float ss = 0.f;
#pragma unroll
                     for (int e = 0; e < 16; ++e) ss += v[e] * v[e];
                     ss = sum4(ss);
                     const float rinv = rsqrtf(ss * (1.f / 64.f) + 1e-6f);
                     const float* gain = (col < 1024) ? qg : kg;
                     const int e0 = col & 63;
                     float gq_[16];
                     load16f(gain + e0, gq_);
#pragma unroll
                     for (int e = 0; e < 16; ++e) v[e] = v[e] * rinv * gq_[e];
                     float pv[16];
#pragma unroll
                     for (int e = 0; e < 16; ++e) pv[e] = xor2(v[e]);
                     if (j >= CL) {
                       const int t = j - CL, sg = (col >> 4) & 3;
                       const float* cs = cosA + t * 32 + (sg & 1) * 16;
                       const float* sn = sinA + t * 32 + (sg & 1) * 16;
                       float cc_[16], sn_[16];
                       load16f(cs, cc_); load16f(sn, sn_);
#pragma unroll
                       for (int e = 0; e < 16; ++e) {
                         const float c = cc_[e], s = sn_[e];
                         v[e] = (sg < 2) ? (v[e] * c - pv[e] * s) : (pv[e] * s + v[e] * c);
                       }
                     }
                     if (col < 1024) store16bf(Q + (size_t)row * D + col, v);
                     else store16bf(Kb + (size_t)row * 256 + (col - 1024), v);
                   } else {
                     store16bf(Vb + (size_t)row * 256 + (col - 1280), v);
                   }
                 });
    } break;
    case PH_L0_ATT: {
      bfu* Q = (bfu*)big; bfu* Kb = (bfu*)(big + SLOT); bfu* Vb = Kb + (size_t)M * 256;
      attn_mfma<0>(smem, Q, (bfu*)(big + 2 * SLOT), nullptr, Kb, 256, nullptr, Vb, 256, 0.125f * 1.4426950408889634f);
    } break;
    case PH_L0_OUT: out_phase(p, smem, 0, (const bfu*)(big + 2 * SLOT), WOUT0, false); break;
    case PH_L0_NORM2: norm_phase(p, smem, 0, 1, -1, false, 0, 2); break;
    case PH_L0_UP: mlp_up_phase(p, smem, false); break;
    case PH_L0_DOWN: mlp_down_phase(p, smem, 0, false); break;
    case PH_L1_NORM1: norm_phase(p, smem, 1, 0, 1, false, 0, 5); break;
    case PH_L1_MIX: {
      bfu* MK = (bfu*)(big + 3 * SLOT);
      bfu* MV = (bfu*)(p.ws + OFF_EX);
      bfu* MR = (bfu*)p.out;
      const float* mu0 = p.in[17];
      const float* mu2 = p.in[17] + 2 * 1024;
      const float* mu3 = p.in[17] + 3 * 1024;
      const int total = M * 64;
      for (int idx = blockIdx.x * NTHR + threadIdx.x; idx < total; idx += gridDim.x * NTHR) {
        const int row = idx >> 6, c0 = (idx & 63) * 16;
        const int j = row % TT;
        const bfu* pu = U + (size_t)row * D + c0;
        const bool hp = (j != 0 && j != CL), hn = (j != CL - 1 && j != TT - 1);
        const uint4 z = make_uint4(0, 0, 0, 0);
        float fc[16], fs[16], ok[16], ov[16], orr[16];
        {
          const uint4 c_0 = *(const uint4*)pu, c_1 = *(const uint4*)(pu + 8);
          const uint4 p_0 = hp ? *(const uint4*)(pu - D) : z, p_1 = hp ? *(const uint4*)(pu - D + 8) : z;
          const uint4 n_0 = hn ? *(const uint4*)(pu + D) : z, n_1 = hn ? *(const uint4*)(pu + D + 8) : z;
          float fp[16], fn[16];
          unpack8(c_0, fc); unpack8(c_1, fc + 8);
          unpack8(p_0, fp); unpack8(p_1, fp + 8);
          unpack8(n_0, fn); unpack8(n_1, fn + 8);
#pragma unroll
          for (int e = 0; e < 16; ++e) fs[e] = 0.5f * (fp[e] + fn[e]) - fc[e];
        }
#pragma unroll
        for (int q = 0; q < 4; ++q) {
          const float4 a = *(const float4*)(mu2 + c0 + 4 * q), bq = *(const float4*)(mu3 + c0 + 4 * q);
          const float4 r4 = *(const float4*)(mu0 + c0 + 4 * q);
          orr[4 * q] = fc[4 * q] + fs[4 * q] * r4.x; orr[4 * q + 1] = fc[4 * q + 1] + fs[4 * q + 1] * r4.y;
          orr[4 * q + 2] = fc[4 * q + 2] + fs[4 * q + 2] * r4.z; orr[4 * q + 3] = fc[4 * q + 3] + fs[4 * q + 3] * r4.w;
          ok[4 * q] = fc[4 * q] + fs[4 * q] * a.x; ok[4 * q + 1] = fc[4 * q + 1] + fs[4 * q + 1] * a.y;
          ok[4 * q + 2] = fc[4 * q + 2] + fs[4 * q + 2] * a.z; ok[4 * q + 3] = fc[4 * q + 3] + fs[4 * q + 3] * a.w;
          ov[4 * q] = fc[4 * q] + fs[4 * q] * bq.x; ov[4 * q + 1] = fc[4 * q + 1] + fs[4 * q + 1] * bq.y;
          ov[4 * q + 2] = fc[4 * q + 2] + fs[4 * q + 2] * bq.z; ov[4 * q + 3] = fc[4 * q + 3] + fs[4 * q + 3] * bq.w;
        }
        store16bf(MK + (size_t)row * D + c0, ok);
        store16bf(MV + (size_t)row * D + c0, ov);
        store16bf(MR + (size_t)row * D + c0, orr);
      }
    } break;
    case PH_L1_IN: {
      bfu* R = (bfu*)big;
      bfu* TW = (bfu*)(p.ws + OFF_TW); bfu* AA = (bfu*)(p.ws + OFF_AA); bfu* SG = (bfu*)(p.ws + OFF_SG);
      const float* mu = p.in[17];
      gemm_phase(smem,
                 [&](int nt) {
                   const int mi = (nt < 8) ? 0 : (nt < 16) ? 2 : (nt < 24) ? 3 : (nt == 24) ? 1 : (nt == 25) ? 4 : 5;
                   const bfu* pre = (nt < 8) ? (const bfu*)p.out
                                  : (nt < 16) ? (const bfu*)(big + 3 * SLOT)
                                  : (nt < 24) ? (const bfu*)(p.ws + OFF_EX) : nullptr;
                   return ALMix{U, mu + mi * 1024, pre};
                 },
                 Wt + W1CAT, 1024, 27, false,
                 [&](int row, int col, float (&v)[16]) {
                   if (col < 3072) {
                     const int which = col >> 10;
                     store16bf(R + (size_t)which * M * D + (size_t)row * D + (col & 1023), v);
                   } else if (col < 3200) {
#pragma unroll
                     for (int e = 0; e < 16; ++e) v[e] = fast_tanh(v[e]);
                     store16bf(TW + (size_t)row * 128 + (col - 3072), v);
                   } else if (col < 3328) {
                     store16bf(AA + (size_t)row * 128 + (col - 3200), v);
                   } else {
#pragma unroll
                     for (int e = 0; e < 16; ++e) v[e] = sigmoidf_(v[e]);
                     store16bf(SG + (size_t)row * 128 + (col - 3328), v);
                   }
                 });
    } break;
    case PH_L1_G: {
      const bfu* SG = (const bfu*)(p.ws + OFF_SG);
      bfu* G = (bfu*)(big + 3 * SLOT);
      gemm_phase(smem, [&](int) { return ALPlain{SG, 128}; }, Wt + G2T, 128, 8, false,
                 [&](int row, int col, float (&v)[16]) { store16bf(G + (size_t)row * D + col, v); });
    } break;
    case PH_L1_SCAN: rwkv_scan(p, smem); break;
    case PH_L1_POST: rwkv_post(p); break;
    case PH_L1_OUT: out_phase(p, smem, 1, (const bfu*)big, WOUT1, false); break;
    case PH_L1_NORM2: norm_phase(p, smem, 1, 1, -1, false, 1, 2); break;
    case PH_L1_UP: mlp_up_phase(p, smem, false); break;
    case PH_L1_DOWN: mlp_down_phase(p, smem, 1, false); break;
    case PH_L2_NORM1: norm_phase(p, smem, 2, 0, 2, false, 1, 5); break;
    case PH_L2_IN: {
      bfu* ZQ = (bfu*)big;
      bfu* ZKV = ZQ + (size_t)M * 512;
      bfu* KR = (bfu*)(p.ws + OFF_TW);
      float* SS = (float*)(p.ws + OFF_SS);
      const float* cosC = (const float*)(p.ws + OFF_ROPEC); const float* sinC = cosC + 2048 * 16;
      gemm_phase(smem, [&](int) { return ALPlain{U, D}; }, Wt + WIN2, 1024, 7, false,
                 [&](int row, int col, float (&v)[16]) {
                   const int b = row / TT, j = row - b * TT;
                   const int nt = col >> 7;
                   float ss = 0.f;
#pragma unroll
                   for (int e = 0; e < 16; ++e) ss += v[e] * v[e];
                   ss = sum8(ss);
                   float pv[16];
#pragma unroll
                   for (int e = 0; e < 16; ++e) pv[e] = xor1(v[e]);
                   if (nt < 6) {
                     if ((col & 127) == 0) SS[(size_t)row * 8 + nt] = ss;
                     if (nt < 4) store16bf(ZQ + (size_t)row * 512 + col, v);
                     else store16bf(ZKV + (size_t)row * 256 + (col - 512), v);
                   } else if (col < 800) {
                     const int sg = (col >> 4) & 1;
                     if (j >= CL) {
                       const int t = j - CL;
                       float cc_[16], sn_[16];
                       load16f(cosC + t * 16, cc_); load16f(sinC + t * 16, sn_);
#pragma unroll
                       for (int e = 0; e < 16; ++e) {
                         const float c = cc_[e], s = sn_[e];
                         v[e] = (sg == 0) ? (v[e] * c - pv[e] * s) : (pv[e] * s + v[e] * c);
                       }
                     }
                     store16bf(KR + (size_t)row * 32 + (col - 768), v);
                   }
                 });
    } break;
    case PH_L2_QKV: {
      const bfu* ZQ = (const bfu*)big;
      const bfu* ZKV = ZQ + (size_t)M * 512;
      const float* SS = (const float*)(p.ws + OFF_SS);
      bfu* QN = (bfu*)(big + SLOT);
      bfu* QR = (bfu*)(big + 2 * SLOT);
      bfu* KN = (bfu*)(big + 3 * SLOT);
      bfu* Vb = (bfu*)(p.ws + OFF_EX);
      const float* cosC = (const float*)(p.ws + OFF_ROPEC); const float* sinC = cosC + 2048 * 16;
      const int ntq = 144 * 12, ntkv = 144 * 16;
      for (int t = blockIdx.x; t < ntq + ntkv; t += gridDim.x) {
        if (t < ntq) {
          const int mt = t / 12, nt = t - mt * 12;
          gemm_tile(smem, ALPlain{ZQ, 512}, Wt + WUQ, 512, 512, mt * 128, nt * 128,
                    [&](int row, int col, float (&v)[16]) {
                      const int b = row / TT, j = row - b * TT;
                      const float4 s4 = *(const float4*)(SS + (size_t)row * 8);
                      const float rinv = rsqrtf((s4.x + s4.y + s4.z + s4.w) * (1.f / 512.f) + 1e-6f);
#pragma unroll
                      for (int e = 0; e < 16; ++e) v[e] *= rinv;
                      float pv[16];
#pragma unroll
                      for (int e = 0; e < 16; ++e) pv[e] = xor1(v[e]);
                      if (col < 1024) {
                        store16bf(QN + (size_t)row * D + col, v);
                      } else {
                        const int sg = (col >> 4) & 1;
                        if (j >= CL) {
                          const int tk = j - CL;
                          float cc_[16], sn_[16];
                          load16f(cosC + tk * 16, cc_); load16f(sinC + tk * 16, sn_);
#pragma unroll
                          for (int e = 0; e < 16; ++e) {
                            const float c = cc_[e], s = sn_[e];
                            v[e] = (sg == 0) ? (v[e] * c - pv[e] * s) : (pv[e] * s + v[e] * c);
                          }
                        }
                        store16bf(QR + (size_t)row * 512 + (col - 1024), v);
                      }
                    });
        } else {
          const int t2 = t - ntq;
          const int mt = t2 >> 4, nt = t2 & 15;
          gemm_tile(smem, ALPlain{ZKV, 256}, Wt + WUKV, 256, 256, mt * 128, nt * 128,
                    [&](int row, int col, float (&v)[16]) {
                      const float rinv = rsqrtf((SS[(size_t)row * 8 + 4] + SS[(size_t)row * 8 + 5]) * (1.f / 256.f) + 1e-6f);
#pragma unroll
                      for (int e = 0; e < 16; ++e) v[e] *= rinv;
                      if (col < 1024) store16bf(KN + (size_t)row * D + col, v);
                      else store16bf(Vb + (size_t)row * D + (col - 1024), v);
                    });
        }
      }
    } break;
    case PH_L2_ATT: {
      bfu* QN = (bfu*)(big + SLOT);
      const bfu* QR = (const bfu*)(big + 2 * SLOT);
      const bfu* KN = (const bfu*)(big + 3 * SLOT);
      const bfu* KR = (const bfu*)(p.ws + OFF_TW);
      const bfu* Vb = (const bfu*)(p.ws + OFF_EX);
      attn_mfma<32>(smem, QN, (bfu*)big, QR, KN, D, KR, Vb, D, 0.10206207261596577f * 1.4426950408889634f);
    } break;
    case PH_L2_OUT: out_phase(p, smem, 2, (const bfu*)big, WOUT2, false); break;
    case PH_L2_NORM2: norm_phase(p, smem, 2, 1, -1, false, 2, 2); break;
    case PH_L2_UP: mlp_up_phase(p, smem, false); break;
    case PH_L2_DOWN: mlp_down_phase(p, smem, 2, false); break;
    case PH_L3_NORM1: norm_phase(p, smem, 3, 0, 3, false, 2, 5); break;
    case PH_L3_IN: {
      bfu* GQ = (bfu*)big; bfu* GK = GQ + (size_t)M * 512;
      bfu* GV = (bfu*)(big + SLOT); bfu* GO = (bfu*)(big + 2 * SLOT);
      float* GD = (float*)(p.ws + OFF_GD);
      gemm_phase(smem, [&](int) { return ALPlain{U, D}; }, Wt + WIN3, 1024, 25, false,
                 [&](int row, int col, float (&v)[16]) {
                   if (col < 512) {
#pragma unroll
                     for (int e = 0; e < 16; ++e) v[e] *= 0.08838834764831845f;
                     store16bf(GQ + (size_t)row * 512 + col, v);
                   } else if (col < 1024) {
                     store16bf(GK + (size_t)row * 512 + (col - 512), v);
                   } else if (col < 2048) {
                     store16bf(GV + (size_t)row * D + (col - 1024), v);
                   } else if (col < 3072) {
                     store16bf(GO + (size_t)row * D + (col - 2048), v);
                   } else if (col < 3104) {
                     float* d = GD + (size_t)row * 32 + (col - 3072);
#pragma unroll
                     for (int q = 0; q < 4; ++q) *(float4*)(d + 4 * q) = make_float4(v[4 * q], v[4 * q + 1], v[4 * q + 2], v[4 * q + 3]);
                   }
                 });
    } break;
    case PH_L3_SCAN: gla_scan(p, smem); break;
    case PH_L3_POST: gla_post(p); break;
    case PH_L3_OUT: out_phase(p, smem, 3, (const bfu*)big, WOUT3, true); break;
    case PH_L3_NORM2: norm_phase(p, smem, 3, 1, -1, true); break;
    case PH_L3_UP: mlp_up_phase(p, smem, true); break;
    case PH_L3_DOWN: mlp_down_phase(p, smem, 3, true); break;
    case PH_FINAL: {
      const int lane = threadIdx.x & 63, wave = threadIdx.x >> 6;
      const float* gn = p.in[60];
      for (int it = blockIdx.x; it < NB * 2048 / 4; it += gridDim.x) {
        const int orow = it * 4 + wave;
        const int b = orow >> 11, t = orow & 2047;
        const float* xr = (const float*)(p.ws + OFF_XR) + ((size_t)b * TT + CL + t) * D;
        float4 x[4];
        float ss = 0.f;
#pragma unroll
        for (int i = 0; i < 4; ++i) {
          x[i] = *(const float4*)(xr + (i * 64 + lane) * 4);
          ss += x[i].x * x[i].x + x[i].y * x[i].y + x[i].z * x[i].z + x[i].w * x[i].w;
        }
        ss = wave_sum(ss);
        const float rinv = rsqrtf(ss * (1.f / 1024.f) + 1e-6f);
        float* o = p.out + (size_t)orow * D;
#pragma unroll
        for (int i = 0; i < 4; ++i) {
          const int c = (i * 64 + lane) * 4;
          const float4 g4 = *(const float4*)(gn + c);
          *(float4*)(o + c) = make_float4(x[i].x * rinv * g4.x, x[i].y * rinv * g4.y, x[i].z * rinv * g4.z, x[i].w * rinv * g4.w);
        }
      }
    } break;
    default: break;
  }
}


#define XB_TMO      128
#define XB_XCNT(j)  (256  + 64 * (j))
#define XB_XSUB(j)  (1280 + 64 * (j))
#define XB_XGEN(j)  (2304 + 64 * (j))
#define XB_TOP      3328
#define XB_TOPGEN   3392
#define XCD_BAR_WORDS 3456
#define XB_SPIN_CAP (1u << 22)
#define LAS __attribute__((address_space(3)))
DEVI unsigned xb_ld(unsigned* p) { return __hip_atomic_load(p, __ATOMIC_RELAXED, __HIP_MEMORY_SCOPE_AGENT); }
DEVI unsigned xb_add(unsigned* p, unsigned v) { return __hip_atomic_fetch_add(p, v, __ATOMIC_RELAXED, __HIP_MEMORY_SCOPE_AGENT); }
DEVI unsigned xb_xcc_id() { return (unsigned)__builtin_amdgcn_s_getreg((3 << 11) | 20) & 0xFu; }
#define XB_SPIN(cond, bar) do { unsigned _sp = 0; while (cond) { __builtin_amdgcn_s_sleep(1); \
    if ((++_sp & 255u) == 0u) { if (xb_ld(&(bar)[XB_TMO])) break; if (_sp > XB_SPIN_CAP) { atomicAdd(&(bar)[XB_TMO], 1u); break; } } } } while (0)
struct XcdBarrier { unsigned* bar; unsigned x; volatile LAS unsigned* st; };
DEVI XcdBarrier xcd_barrier_post(unsigned* bar, volatile LAS unsigned* st) {
  XcdBarrier b; b.bar = bar; b.x = xb_xcc_id(); b.st = st;
  if (threadIdx.x == 0) (void)xb_add(&bar[XB_XCNT(b.x)], 1u);
  return b;
}
DEVI void xcd_barrier_complete(unsigned* bar, unsigned x, unsigned& nloc, unsigned& nx) {
  const unsigned G = gridDim.x * gridDim.y * gridDim.z;
  unsigned sum, cnt, mine, sp = 0u;
  for (;;) {
    sum = 0u; cnt = 0u; mine = 0u;
#pragma unroll
    for (unsigned j = 0; j < 16; ++j) { const unsigned c = xb_ld(&bar[XB_XCNT(j)]); sum += c; cnt += (c > 0u) ? 1u : 0u; mine = (j == x) ? c : mine; }
    if (sum == G) break;
    __builtin_amdgcn_s_sleep(1);
    if ((++sp & 255u) == 0u) { if (xb_ld(&bar[XB_TMO])) break; if (sp > XB_SPIN_CAP) { atomicAdd(&bar[XB_TMO], 1u); break; } }
  }
  nloc = mine > 0u ? mine : 1u; nx = cnt > 0u ? cnt : 1u;
}
DEVI void xcd_barrier(const XcdBarrier& b) {
  asm volatile("s_waitcnt vmcnt(0)" ::: "memory");
  __syncthreads();
  if (threadIdx.x == 0) {
    unsigned* bar = b.bar;
    __builtin_amdgcn_s_waitcnt(0);
    unsigned nloc = b.st[0], nx = b.st[1];
    if (nloc == 0u) { xcd_barrier_complete(bar, b.x, nloc, nx); b.st[0] = nloc; b.st[1] = nx; }
    const unsigned old = xb_add(&bar[XB_XSUB(b.x)], 1u);
    const unsigned gen = old / nloc;
    if (old + 1u == (gen + 1u) * nloc) {
      __builtin_amdgcn_fence(__ATOMIC_RELEASE, "agent");
      asm volatile("s_waitcnt vmcnt(0)" ::: "memory");
      const unsigned og = xb_add(&bar[XB_TOP], 1u);
      const unsigned tg = og / nx;
      if (og + 1u == (tg + 1u) * nx) xb_add(&bar[XB_TOPGEN], 1u);
      else XB_SPIN(xb_ld(&bar[XB_TOPGEN]) == tg, bar);
      __builtin_amdgcn_fence(__ATOMIC_ACQUIRE, "agent");
      xb_add(&bar[XB_XGEN(b.x)], 1u);
      asm volatile("s_waitcnt vmcnt(0)" ::: "memory");
    } else {
      XB_SPIN(xb_ld(&bar[XB_XGEN(b.x)]) == gen, bar);
      __builtin_amdgcn_fence(__ATOMIC_ACQUIRE, "agent");
      asm volatile("s_waitcnt vmcnt(0)" ::: "memory");
    }
  }
  __syncthreads();
}

__global__ void __launch_bounds__(NTHR, 2) mega_kernel(Params p) {
  extern __shared__ __attribute__((aligned(16))) unsigned char smem[];
  cg::grid_group grid = cg::this_grid();
  __shared__ uint4 xb_words;
  if (threadIdx.x == 0) xb_words = make_uint4(0u, 0u, 0u, 0u);
  __syncthreads();
  XcdBarrier xb;
  xb.bar = (unsigned*)(p.ws + WS_BAR); xb.x = xb_xcc_id(); xb.st = (volatile LAS unsigned*)&xb_words;
  unsigned my_rank = 0;
  if (threadIdx.x == 0) my_rank = xb_add(&xb.bar[XB_XCNT(xb.x)], 1u);
  if (threadIdx.x == 0) xmap_ref() = make_int4((int)(blockIdx.x & 7), (int)(blockIdx.x >> 3), 0, 0);
#define GSYNC(PH) do { if ((PH) == 0) grid.sync(); else xcd_barrier(xb); } while (0)
#define RUN(PH) if (p.ph_lo <= (PH) && (PH) < p.ph_hi) { \
    if (PROBE_DUP(PH)) { run_phase<PH>(p, smem); xcd_barrier(xb); } \
    run_phase<PH>(p, smem); if ((PH) + 1 < p.ph_hi) GSYNC(PH); }
  RUN(0)
  if (threadIdx.x == 0) {
    bool ok = (gridDim.x & 7) == 0;
    for (unsigned j = 0; j < 8; ++j) ok = ok && (xb_ld(&xb.bar[XB_XCNT(j)]) == (gridDim.x >> 3));
    if (ok) xmap_ref() = make_int4((int)xb.x, (int)my_rank, 1, 0);
  }
  __syncthreads();
  RUN(1) RUN(2) RUN(3) RUN(4) RUN(5) RUN(6) RUN(7) RUN(8) RUN(9) RUN(10) RUN(11) RUN(12) RUN(13) RUN(14) RUN(15) RUN(16)
  RUN(17) RUN(18) RUN(19) RUN(20) RUN(21) RUN(22) RUN(23) RUN(24) RUN(25) RUN(26) RUN(27) RUN(28) RUN(29) RUN(30) RUN(31) RUN(32) RUN(33) RUN(34)
#undef RUN
  static_assert(NPHASES == 35, "phase count");
#ifdef PROBE_SYNCS
  for (int i = 0; i < PROBE_SYNCS; ++i) grid.sync();
#endif
}

extern "C" void kernel_launch(void* const* d_in, const int* in_sizes, int n_in, void* d_out, int out_size,
                              void* d_ws, size_t ws_size, hipStream_t stream) {
  static int grid_blocks = 0;
  if (grid_blocks == 0) {
    if (n_in != 61 || ws_size < WS_END) {
      fprintf(stderr, "kernel_launch: need 61 inputs and >= %zu bytes of workspace (got %d, %zu)\n", (size_t)WS_END, n_in, ws_size);
      grid_blocks = -1;
      return;
    }
    int dev = 0, cus = 0, per_cu = 0;
    hipGetDevice(&dev);
    hipDeviceGetAttribute(&cus, hipDeviceAttributeMultiprocessorCount, dev);
    hipFuncSetAttribute((const void*)mega_kernel, hipFuncAttributeMaxDynamicSharedMemorySize, LDS_BYTES);
    hipOccupancyMaxActiveBlocksPerMultiprocessor(&per_cu, (const void*)mega_kernel, NTHR, LDS_BYTES);
    if (per_cu < 1) { fprintf(stderr, "kernel_launch: occupancy query returned %d\n", per_cu); grid_blocks = -1; return; }
    if (per_cu > 2) per_cu = 2;
    grid_blocks = cus * per_cu;
  }
  if (grid_blocks < 0) return;
  (void)hipMemsetAsync((char*)d_ws + WS_BAR, 0, 16384, stream);
  Params p{};
  for (int i = 0; i < 61; ++i) p.in[i] = (const float*)d_in[i];
  p.out = (float*)d_out;
  p.ws = (unsigned char*)d_ws;
  p.ph_lo = 0;
  p.ph_hi = NPHASES;
  void* args[] = {&p};
  hipError_t e = hipLaunchCooperativeKernel((const void*)mega_kernel, dim3(grid_blocks), dim3(NTHR), args, LDS_BYTES, stream);
  if (e != hipSuccess) fprintf(stderr, "cooperative launch failed: %s (grid %d)\n", hipGetErrorString(e), grid_blocks);
}
```

```cpp
#include <hip/hip_runtime.h>
#include <hip/hip_cooperative_groups.h>
#include <stdint.h>
#include <cstdio>
namespace cg = cooperative_groups;

#define DEVI __device__ __forceinline__
typedef unsigned short bfu;
using bf16x8 = __attribute__((ext_vector_type(8))) short;
using f32x16 = __attribute__((ext_vector_type(16))) float;
using f32x4 = __attribute__((ext_vector_type(4))) float;

constexpr int D = 1024, NB = 8, TT = 2304, CL = 256, M = NB * TT;
constexpr int NTHR = 256;
constexpr int LDS_BYTES = 75776;

constexpr size_t SLOT = (size_t)M * 1024 * 2;
constexpr size_t OFF_W = 0;
constexpr size_t W_BYTES = 27262976;
constexpr size_t OFF_XR = OFF_W + W_BYTES;
constexpr size_t OFF_U = OFF_XR + (size_t)M * 1024 * 4;
constexpr size_t OFF_BIG = OFF_U + SLOT;
constexpr size_t OFF_EX = OFF_BIG + 4 * SLOT;
constexpr size_t OFF_TW = OFF_EX + SLOT;
constexpr size_t OFF_AA = OFF_TW + (size_t)M * 128 * 2;
constexpr size_t OFF_SG = OFF_AA + (size_t)M * 128 * 2;
constexpr size_t OFF_BON = OFF_SG + (size_t)M * 128 * 2;
constexpr size_t OFF_GD = OFF_BON + (size_t)2 * M * 16 * 4;
constexpr size_t OFF_SS = OFF_GD + (size_t)M * 32 * 4;
constexpr size_t OFF_MOD = OFF_SS + (size_t)M * 8 * 4;
constexpr size_t OFF_ROPEA = OFF_MOD + (size_t)4 * 9 * 6144 * 4;
constexpr size_t OFF_ROPEC = OFF_ROPEA + (size_t)2 * 2048 * 32 * 4;
constexpr size_t WS_BAR = OFF_ROPEC + (size_t)2 * 2048 * 16 * 4;
constexpr size_t WS_END = WS_BAR + 16384;

constexpr int WUP = 0, WDN = 4194304, MW = 8388608;
constexpr int WIN0 = MW, WOUT0 = MW + 1572864;
constexpr int W1CAT = MW, G2T = MW + 3538944, W2T = G2T + 131072, A2T = W2T + 131072, WOUT1 = A2T + 131072;
constexpr int WIN2 = MW, WUQ = MW + 917504, WUKV = WUQ + 786432, WOUT2 = WUKV + 524288;
constexpr int WIN3 = MW, WOUT3 = MW + 3276800;

struct Params {
  const float* in[61];
  float* out;
  unsigned char* ws;
  int ph_lo, ph_hi;
};

struct ConvJob { int in_idx, src_off, src_ld, K, ngroups, grp_w, grp_stride, dst_off, scale_idx; };

__constant__ ConvJob g_jobs[] = {
  {12, 0, 4096, 1024, 64, 64, 64, WUP, -1},
  {13, 0, 1024, 4096, 16, 64, 64, WDN, -1},
  {7, 0, 1536, 1024, 24, 64, 64, WIN0, -1},
  {10, 0, 1024, 1024, 16, 64, 64, WOUT0, -1},
  {34, 0, 4096, 1024, 64, 64, 64, WUP, -1},
  {35, 0, 1024, 4096, 16, 64, 64, WDN, -1},
  {18, 0, 1024, 1024, 16, 64, 64, W1CAT, -1},
  {18, 1048576, 1024, 1024, 16, 64, 64, W1CAT + 1024 * 1024, -1},
  {18, 2097152, 1024, 1024, 16, 64, 64, W1CAT + 2048 * 1024, -1},
  {20, 0, 64, 1024, 1, 64, 64, W1CAT + 3072 * 1024, -1},
  {20, 65536, 64, 1024, 1, 64, 64, W1CAT + 3136 * 1024, -1},
  {23, 0, 64, 1024, 1, 64, 64, W1CAT + 3200 * 1024, -1},
  {23, 65536, 64, 1024, 1, 64, 64, W1CAT + 3264 * 1024, -1},
  {25, 0, 128, 1024, 2, 64, 64, W1CAT + 3328 * 1024, -1},
  {26, 0, 1024, 128, 16, 64, 64, G2T, -1},
  {21, 0, 1024, 64, 16, 64, 64, W2T, -1},
  {21, 65536, 1024, 64, 16, 64, 64, W2T + 65536, -1},
  {24, 0, 1024, 64, 16, 64, 64, A2T, -1},
  {24, 65536, 1024, 64, 16, 64, 64, A2T + 65536, -1},
  {32, 0, 1024, 1024, 16, 64, 64, WOUT1, -1},
  {46, 0, 4096, 1024, 64, 64, 64, WUP, -1},
  {47, 0, 1024, 4096, 16, 64, 64, WDN, -1},
  {39, 0, 800, 1024, 25, 32, 32, WIN2, -1},
  {42, 0, 1536, 512, 16, 64, 96, WUQ, 40},
  {42, 64, 1536, 512, 16, 32, 96, WUQ + 1024 * 512, 40},
  {43, 0, 2048, 256, 16, 64, 128, WUKV, 41},
  {43, 64, 2048, 256, 16, 64, 128, WUKV + 1024 * 256, 41},
  {44, 0, 1024, 1024, 16, 64, 64, WOUT2, -1},
  {58, 0, 4096, 1024, 64, 64, 64, WUP, -1},
  {59, 0, 1024, 4096, 16, 64, 64, WDN, -1},
  {51, 0, 3072, 1024, 48, 64, 64, WIN3, -1},
  {52, 0, 16, 1024, 1, 16, 16, WIN3 + 3072 * 1024, -1},
  {52, 16384, 16, 1024, 1, 16, 16, WIN3 + 3088 * 1024, -1},
  {56, 0, 1024, 1024, 16, 64, 64, WOUT3, -1},
};
__constant__ int g_job_lo[5] = {0, 4, 20, 28, 34};

typedef __bf16 hwbf2 __attribute__((ext_vector_type(2)));
typedef float hwf2 __attribute__((ext_vector_type(2)));
DEVI unsigned pack2(float a, float b) {
  const hwf2 v = {a, b};
  return __builtin_bit_cast(unsigned, __builtin_convertvector(v, hwbf2));
}
DEVI unsigned short f2bf(float f) { return (unsigned short)(pack2(f, 0.f) & 0xffffu); }
DEVI float bf2f(unsigned short h) { return __uint_as_float(((unsigned)h) << 16); }
DEVI float bflo(unsigned w) { return __uint_as_float(w << 16); }
DEVI float bfhi(unsigned w) { return __uint_as_float(w & 0xffff0000u); }
DEVI void unpack8(const uint4& q, float* f) {
  f[0] = bflo(q.x); f[1] = bfhi(q.x); f[2] = bflo(q.y); f[3] = bfhi(q.y);
  f[4] = bflo(q.z); f[5] = bfhi(q.z); f[6] = bflo(q.w); f[7] = bfhi(q.w);
}
DEVI uint4 pack8(const float* f) {
  uint4 q; q.x = pack2(f[0], f[1]); q.y = pack2(f[2], f[3]); q.z = pack2(f[4], f[5]); q.w = pack2(f[6], f[7]);
  return q;
}
DEVI void store16bf(bfu* dst, const float* v) {
  *(uint4*)dst = pack8(v);
  *(uint4*)(dst + 8) = pack8(v + 8);
}
template <int CTRL>
DEVI float dpp_mov(float v) { return __int_as_float(__builtin_amdgcn_update_dpp(0, __float_as_int(v), CTRL, 0xF, 0xF, true)); }
DEVI float sum8(float v) {
  v += dpp_mov<0xB1>(v);
  v += dpp_mov<0x4E>(v);
  v += dpp_mov<0x141>(v);
  return v;
}
DEVI float xor1(float v) { return dpp_mov<0xB1>(v); }
DEVI float xor2(float v) { return dpp_mov<0x4E>(v); }
DEVI float sum4(float v) { v += xor1(v); v += xor2(v); return v; }
DEVI float sum16(float v) { v = sum8(v); v += dpp_mov<0x140>(v); return v; }
DEVI float wave_sum(float v) {
  v = sum8(v);
  v += dpp_mov<0x140>(v);
  const int vi = __float_as_int(v);
  const float r0 = __int_as_float(__builtin_amdgcn_readlane(vi, 0)), r1 = __int_as_float(__builtin_amdgcn_readlane(vi, 16));
  const float r2 = __int_as_float(__builtin_amdgcn_readlane(vi, 32)), r3 = __int_as_float(__builtin_amdgcn_readlane(vi, 48));
  return (r0 + r1) + (r2 + r3);
}
DEVI int4& xmap_ref() { __shared__ int4 m; return m; }
DEVI float sigmoidf_(float x) { return 1.f / (1.f + __expf(-x)); }
DEVI float softplusf_(float x) { return fmaxf(x, 0.f) + log1pf(__expf(-fabsf(x))); }

DEVI void conv_unit(const Params& p, const ConvJob& J, int ul, float* tile) {
  const int tid = threadIdx.x;
  const int nsub = (J.grp_w + 63) >> 6;
  const int per_k = J.ngroups * nsub;
  const int kt = ul / per_k;
  const int rem = ul - kt * per_k;
  const int g = rem / nsub, sub = rem - g * nsub;
  const int nvalid = min(64, J.grp_w - sub * 64);
  const float* src = p.in[J.in_idx] + J.src_off + g * J.grp_stride + sub * 64;
  const float* scale = (J.scale_idx >= 0) ? p.in[J.scale_idx] : nullptr;
  const int k0 = kt * 64;
  {
    const int n4 = (tid & 15) * 4, kr = tid >> 4;
#pragma unroll
    for (int i = 0; i < 4; ++i) {
      const int k = kr + 16 * i;
      float4 v = make_float4(0.f, 0.f, 0.f, 0.f);
      if (n4 < nvalid) v = *(const float4*)(src + (size_t)(k0 + k) * J.src_ld + n4);
      if (scale) { const float s = scale[k0 + k]; v.x *= s; v.y *= s; v.z *= s; v.w *= s; }
      *(float4*)(tile + k * 68 + n4) = v;
    }
  }
  __syncthreads();
  {
    const int nn = tid >> 2, ks = (tid & 3) * 16;
    if (nn < nvalid) {
      float f[16];
#pragma unroll
      for (int e = 0; e < 16; ++e) f[e] = tile[(ks + e) * 68 + nn];
      bfu* dst = (bfu*)(p.ws + OFF_W) + J.dst_off + (size_t)(g * J.grp_w + sub * 64 + nn) * J.K + k0 + ks;
      *(uint4*)dst = pack8(f);
      *(uint4*)(dst + 8) = pack8(f + 8);
    }
  }
  __syncthreads();
}

DEVI int job_units(const ConvJob& J) { return (J.K >> 6) * J.ngroups * ((J.grp_w + 63) >> 6); }

DEVI int conv_total_units(int layer) {
  int tot = 0;
  for (int j = g_job_lo[layer]; j < g_job_lo[layer + 1]; ++j) tot += job_units(g_jobs[j]);
  return tot;
}
DEVI void conv_do(const Params& p, int layer, int u, float* tile) {
  int j = g_job_lo[layer];
  for (;; ++j) {
    int n = job_units(g_jobs[j]);
    if (u < n) break;
    u -= n;
  }
  conv_unit(p, g_jobs[j], u, tile);
}

DEVI void norm_one(const Params& p, int layer, int which, int row, float4 (&x)[4], bool skip_ctx, int fix_layer, int fix_chunk) {
  const int lane = threadIdx.x & 63;
  const int b = row / TT, j = row - b * TT;
  if (skip_ctx && j < CL) return;
  const int midx = (j < CL) ? 8 : b;
  const float* xr = (const float*)(p.ws + OFF_XR) + (size_t)row * D;
  const float* mod = (const float*)(p.ws + OFF_MOD) + ((size_t)layer * 9 + midx) * 6144;
  const float* shift = mod + (which ? 3 : 0) * 1024;
  const float* scl = mod + (which ? 4 : 1) * 1024;
  const int nidx[4][2] = {{6, 11}, {16, 33}, {38, 45}, {50, 57}};
  const float* gn = p.in[nidx[layer][which]];
  float ss = 0.f;
  if (fix_layer >= 0) {
    const int mt = row >> 7, xg = mt / 18, ml = mt - xg * 18;
    if (ml >= 16) {
      const int lrow = (xg * 2 + (ml - 16)) * 128 + (row & 127);
      const float* P = (const float*)(p.ws + OFF_EX) + (size_t)lrow * D;
      const float* gate = (const float*)(p.ws + OFF_MOD) + ((size_t)fix_layer * 9 + midx) * 6144 + fix_chunk * 1024;
      float* xw = (float*)(p.ws + OFF_XR) + (size_t)row * D;
#pragma unroll
      for (int i = 0; i < 4; ++i) {
        const int c = (i * 64 + lane) * 4;
        float4 s = *(const float4*)(P + c);
#pragma unroll
        for (int q = 1; q < 4; ++q) {
          const float4 t = *(const float4*)(P + (size_t)q * 2048 * D + c);
          s.x += t.x; s.y += t.y; s.z += t.z; s.w += t.w;
        }
        const float4 g = *(const float4*)(gate + c);
        x[i].x += g.x * s.x; x[i].y += g.y * s.y; x[i].z += g.z * s.z; x[i].w += g.w * s.w;
        *(float4*)(xw + c) = x[i];
      }
    }
  }
#pragma unroll
  for (int i = 0; i < 4; ++i) ss += x[i].x * x[i].x + x[i].y * x[i].y + x[i].z * x[i].z + x[i].w * x[i].w;
  ss = wave_sum(ss);
  const float rinv = rsqrtf(ss * (1.f / 1024.f) + 1e-6f);
  bfu* u = (bfu*)(p.ws + OFF_U) + (size_t)row * D;
#pragma unroll
  for (int i = 0; i < 4; ++i) {
    const int c = (i * 64 + lane) * 4;
    float4 g4 = *(const float4*)(gn + c), s4 = *(const float4*)(scl + c), h4 = *(const float4*)(shift + c);
    float o0 = x[i].x * rinv * g4.x * (1.f + s4.x) + h4.x;
    float o1 = x[i].y * rinv * g4.y * (1.f + s4.y) + h4.y;
    float o2 = x[i].z * rinv * g4.z * (1.f + s4.z) + h4.z;
    float o3 = x[i].w * rinv * g4.w * (1.f + s4.w) + h4.w;
    uint2 w; w.x = pack2(o0, o1); w.y = pack2(o2, o3);
    *(uint2*)(u + c) = w;
  }
}

DEVI void norm_rows(const Params& p, int layer, int which, int item, bool skip_ctx, int fix_layer, int fix_chunk) {
  const int lane = threadIdx.x & 63, wave = threadIdx.x >> 6;
  const int rowA = item * 8 + wave, rowB = rowA + 4;
  const bool first = (layer == 0 && which == 0);
  const float* xa; const float* xb;
  if (first) {
    const int bA = rowA / TT, jA = rowA - bA * TT, bB = rowB / TT, jB = rowB - bB * TT;
    xa = (jA < CL) ? (p.in[2] + ((size_t)bA * CL + jA) * D) : (p.in[0] + ((size_t)bA * 2048 + (jA - CL)) * D);
    xb = (jB < CL) ? (p.in[2] + ((size_t)bB * CL + jB) * D) : (p.in[0] + ((size_t)bB * 2048 + (jB - CL)) * D);
  } else {
    xa = (const float*)(p.ws + OFF_XR) + (size_t)rowA * D;
    xb = (const float*)(p.ws + OFF_XR) + (size_t)rowB * D;
  }
  float4 a[4], b[4];
#pragma unroll
  for (int i = 0; i < 4; ++i) { a[i] = *(const float4*)(xa + (i * 64 + lane) * 4); b[i] = *(const float4*)(xb + (i * 64 + lane) * 4); }
  if (first) {
    float* wa = (float*)(p.ws + OFF_XR) + (size_t)rowA * D;
    float* wb = (float*)(p.ws + OFF_XR) + (size_t)rowB * D;
#pragma unroll
    for (int i = 0; i < 4; ++i) { *(float4*)(wa + (i * 64 + lane) * 4) = a[i]; *(float4*)(wb + (i * 64 + lane) * 4) = b[i]; }
  }
  norm_one(p, layer, which, rowA, a, skip_ctx, fix_layer, fix_chunk);
  norm_one(p, layer, which, rowB, b, skip_ctx, fix_layer, fix_chunk);
}

struct ALPlain {
  static constexpr bool kPlain = true;
  const bfu* A; int lda;
  DEVI uint4 operator()(int row, int k) const { return *(const uint4*)(A + (size_t)row * lda + k); }
};
struct ALMix {
  static constexpr bool kPlain = false;
  const bfu* U; const float* mu; const bfu* P;
  DEVI uint4 operator()(int row, int k) const {
    if (P) return *(const uint4*)(P + (size_t)row * D + k);
    const int j = row % TT;
    const bfu* pu = U + (size_t)row * D + k;
    uint4 c = *(const uint4*)pu;
    uint4 z = make_uint4(0, 0, 0, 0);
    uint4 pv = (j != 0 && j != CL) ? *(const uint4*)(pu - D) : z;
    uint4 nx = (j != CL - 1 && j != TT - 1) ? *(const uint4*)(pu + D) : z;
    float fc[8], fp[8], fn[8], o[8];
    unpack8(c, fc); unpack8(pv, fp); unpack8(nx, fn);
    float4 m0 = *(const float4*)(mu + k), m1 = *(const float4*)(mu + k + 4);
    const float mm[8] = {m0.x, m0.y, m0.z, m0.w, m1.x, m1.y, m1.z, m1.w};
#pragma unroll
    for (int e = 0; e < 8; ++e) o[e] = fc[e] + (0.5f * (fp[e] + fn[e]) - fc[e]) * mm[e];
    return pack8(o);
  }
};

template <class AL, class EP>
DEVI void gemm_tile(unsigned char* smem, const AL& al, const bfu* __restrict__ Bt, int ldb, int K, int row0, int col0, EP&& ep) {
  const int tid = threadIdx.x, lane = tid & 63, wave = tid >> 6;
  const int wm = wave >> 1, wn = wave & 1;
  bfu* S0 = (bfu*)smem;
  f32x4 acc[4][4];
#pragma unroll
  for (int a = 0; a < 4; ++a)
#pragma unroll
    for (int b = 0; b < 4; ++b) acc[a][b] = f32x4{0.f, 0.f, 0.f, 0.f};
  const int nk = K >> 6;
  const int dr = lane >> 3, dp = lane & 7;
  const int lr = tid >> 3, lc = tid & 7;
  const int l15 = lane & 15, g4 = lane >> 4;
  const int swz = (l15 >> 1) & 7;
  uint4 ra[4];
  auto issue = [&](int kt, int st) {
    bfu* As = S0 + st * 16384;
    bfu* Bs = As + 8192;
#pragma unroll
    for (int i = 0; i < 4; ++i) {
      const int R = wave * 32 + i * 8 + dr;
      const int c = dp ^ ((R >> 1) & 7);
      __builtin_amdgcn_global_load_lds((const unsigned*)(Bt + (size_t)(col0 + R) * ldb + kt * 64 + c * 8),
                                       (unsigned*)(Bs + (wave * 32 + i * 8) * 64 + lane * 8), 16, 0, 0);
      if constexpr (AL::kPlain)
        __builtin_amdgcn_global_load_lds((const unsigned*)(al.A + (size_t)(row0 + R) * al.lda + kt * 64 + c * 8),
                                         (unsigned*)(As + (wave * 32 + i * 8) * 64 + lane * 8), 16, 0, 0);
    }
  };
  auto aload = [&](int kt) {
    if constexpr (!AL::kPlain) {
#pragma unroll
      for (int i = 0; i < 4; ++i) ra[i] = al(row0 + lr + 32 * i, kt * 64 + lc * 8);
    }
  };
  auto awrite = [&](int st) {
    if constexpr (!AL::kPlain) {
      bfu* As = S0 + st * 16384;
#pragma unroll
      for (int i = 0; i < 4; ++i) {
        const int r = lr + 32 * i;
        *(uint4*)(As + r * 64 + ((lc ^ ((r >> 1) & 7)) * 8)) = ra[i];
      }
    }
  };
  issue(0, 0);
  aload(0);
  awrite(0);
  __syncthreads();
  for (int kt = 0; kt < nk; ++kt) {
    const int cur = kt & 1;
    const bool more = (kt + 1 < nk);
    if (more) { issue(kt + 1, cur ^ 1); aload(kt + 1); }
    const bfu* Ac = S0 + cur * 16384 + (wm * 64 + l15) * 64;
    const bfu* Bc = S0 + cur * 16384 + 8192 + (wn * 64 + l15) * 64;
#pragma unroll
    for (int ks = 0; ks < 2; ++ks) {
      const int po = ((ks * 4 + g4) ^ swz) * 8;
      bf16x8 af[4], bq[4];
#pragma unroll
      for (int i = 0; i < 4; ++i) {
        af[i] = *(const bf16x8*)(Ac + i * 16 * 64 + po);
        bq[i] = *(const bf16x8*)(Bc + i * 16 * 64 + po);
      }
      __builtin_amdgcn_s_setprio(1);
#pragma unroll
      for (int a = 0; a < 4; ++a)
#pragma unroll
        for (int b = 0; b < 4; ++b) acc[a][b] = __builtin_amdgcn_mfma_f32_16x16x32_bf16(af[a], bq[b], acc[a][b], 0, 0, 0);
      __builtin_amdgcn_s_setprio(0);
    }
    if (more) awrite(cur ^ 1);
    __syncthreads();
  }
  float* Cs = (float*)smem;
#pragma unroll
  for (int mi = 0; mi < 4; ++mi)
#pragma unroll
    for (int ni = 0; ni < 4; ++ni)
#pragma unroll
      for (int r = 0; r < 4; ++r) {
        const int row = wm * 64 + mi * 16 + 4 * g4 + r;
        const int col = wn * 64 + ni * 16 + l15;
        Cs[row * 132 + col] = acc[mi][ni][r];
      }
  __syncthreads();
#pragma unroll 1
  for (int ps = 0; ps < 4; ++ps) {
    const int idx = ps * 256 + tid;
    const int r = idx >> 3, seg = idx & 7;
    float v[16];
    const float4* src = (const float4*)(Cs + r * 132 + seg * 16);
#pragma unroll
    for (int q = 0; q < 4; ++q) {
      float4 t = src[q];
      v[4 * q] = t.x; v[4 * q + 1] = t.y; v[4 * q + 2] = t.z; v[4 * q + 3] = t.w;
    }
    ep(row0 + r, col0 + seg * 16, v);
  }
  __syncthreads();
}

DEVI int rowtile0(int mt, bool skip_ctx) {
  if (!skip_ctx) return mt * 128;
  const int b = mt >> 4, t = mt & 15;
  return b * TT + CL + t * 128;
}

template <class ALF, class EP>
DEVI void gemm_phase(unsigned char* smem, ALF&& alf, const bfu* Bt, int K, int NT, bool skip_ctx, EP&& ep) {
  const int MT = skip_ctx ? 128 : 144;
  if (gridDim.x & 7) {
    const int ntiles = MT * NT;
    for (int t = blockIdx.x; t < ntiles; t += gridDim.x) {
      const int mt = t / NT, nt = t - mt * NT;
      auto al = alf(nt);
      gemm_tile(smem, al, Bt, K, K, rowtile0(mt, skip_ctx), nt * 128, ep);
    }
    return;
  }
  const int4 xm = xmap_ref();
  const int nx = gridDim.x >> 3, xcd = xm.x, j = xm.y;
  const int mts = MT >> 3, per_xcd = mts * NT;
  for (int lt = j; lt < per_xcd; lt += nx) {
    int q = lt, ng = 0, gw = min(8, NT);
    while (q >= mts * gw) { q -= mts * gw; ++ng; gw = min(8, NT - 8 * ng); }
    const int ml = q / gw, nl = q - ml * gw;
    const int mt = xcd * mts + ml, nt = ng * 8 + nl;
    auto al = alf(nt);
    gemm_tile(smem, al, Bt, K, K, rowtile0(mt, skip_ctx), nt * 128, ep);
  }
}

template <int DX>
DEVI void attn_mfma(unsigned char* smem, const bfu* Q, bfu* O, const bfu* QX, const bfu* Kp, int ldk, const bfu* KX,
                    const bfu* Vp, int ldv, float sc) {
  constexpr int DQ = 64 + DX, KS = DQ + 8, NKS = DQ / 16;
  constexpr int KBUF = 64 * KS, VS = 68, VBUF = 64 * VS;
  bfu* Ksm = (bfu*)smem;
  bfu* Vsm = Ksm + 2 * KBUF;
  const int tid = threadIdx.x, lane = tid & 63, wave = tid >> 6, l31 = lane & 31, hh = lane >> 5;
  for (int it = blockIdx.x; it < 2304; it += gridDim.x) {
    int b, hq, kvh, qrow, nkeys;
    if (DX == 0) {
      int qb;
      if (it < 2048) { b = it >> 8; const int rem = it & 255; kvh = rem >> 6; qb = 8 + (rem & 63); }
      else { const int i2 = it - 2048; b = i2 >> 5; const int rem = i2 & 31; kvh = rem >> 3; qb = rem & 7; }
      hq = kvh * 4 + wave; qrow = b * TT + qb * 32; nkeys = (qb < 8) ? CL : TT;
    } else {
      int qb;
      if (it < 2048) { b = it >> 8; const int rem = it & 255; hq = rem >> 4; qb = 2 + (rem & 15); }
      else { const int i2 = it - 2048; b = i2 >> 5; const int rem = i2 & 31; hq = rem >> 1; qb = rem & 1; }
      kvh = hq; qrow = b * TT + qb * 128 + wave * 32; nkeys = (qb < 2) ? CL : TT;
    }
    const bfu* Kbase = Kp + (size_t)(b * TT) * ldk + kvh * 64;
    const bfu* KXbase = DX ? (KX + (size_t)(b * TT) * 32) : nullptr;
    const bfu* Vbase = Vp + (size_t)(b * TT) * ldv + kvh * 64;
    bf16x8 qf[NKS];
    {
      const bfu* qp = Q + (size_t)(qrow + l31) * D + hq * 64 + 8 * hh;
#pragma unroll
      for (int ks = 0; ks < 4; ++ks) qf[ks] = *(const bf16x8*)(qp + ks * 16);
      if (DX) {
        const bfu* qx = QX + (size_t)(qrow + l31) * 512 + hq * 32 + 8 * hh;
#pragma unroll
        for (int ks = 0; ks < DX / 16; ++ks) qf[4 + ks] = *(const bf16x8*)(qx + ks * 16);
      }
    }
    f32x16 ot[2];
#pragma unroll
    for (int e = 0; e < 16; ++e) { ot[0][e] = 0.f; ot[1][e] = 0.f; }
    float mrun = -1e30f, lrun = 0.f;
    uint4 rk0, rk1, rkx, rv0, rv1;
    const int kkey = tid >> 3, kkc = (tid & 7) * 8;
    const int xkey = tid >> 2, xkc = (tid & 3) * 8;
    const int vkp = tid & 31, vds = tid >> 5;
    auto gload = [&](int k0) {
      rk0 = *(const uint4*)(Kbase + (size_t)(k0 + kkey) * ldk + kkc);
      rk1 = *(const uint4*)(Kbase + (size_t)(k0 + kkey + 32) * ldk + kkc);
      if (DX) rkx = *(const uint4*)(KXbase + (size_t)(k0 + xkey) * 32 + xkc);
      rv0 = *(const uint4*)(Vbase + (size_t)(k0 + 2 * vkp) * ldv + vds * 8);
      rv1 = *(const uint4*)(Vbase + (size_t)(k0 + 2 * vkp + 1) * ldv + vds * 8);
    };
    auto lstore = [&](int buf) {
      bfu* kb = Ksm + buf * KBUF;
      *(uint4*)(kb + kkey * KS + kkc) = rk0;
      *(uint4*)(kb + (kkey + 32) * KS + kkc) = rk1;
      if (DX) *(uint4*)(kb + xkey * KS + 64 + xkc) = rkx;
      bfu* vb = Vsm + buf * VBUF + (vds * 8) * VS + 2 * vkp;
      *(unsigned*)(vb + 0 * VS) = (rv0.x & 0xffffu) | (rv1.x << 16);
      *(unsigned*)(vb + 1 * VS) = (rv0.x >> 16) | (rv1.x & 0xffff0000u);
      *(unsigned*)(vb + 2 * VS) = (rv0.y & 0xffffu) | (rv1.y << 16);
      *(unsigned*)(vb + 3 * VS) = (rv0.y >> 16) | (rv1.y & 0xffff0000u);
      *(unsigned*)(vb + 4 * VS) = (rv0.z & 0xffffu) | (rv1.z << 16);
      *(unsigned*)(vb + 5 * VS) = (rv0.z >> 16) | (rv1.z & 0xffff0000u);
      *(unsigned*)(vb + 6 * VS) = (rv0.w & 0xffffu) | (rv1.w << 16);
      *(unsigned*)(vb + 7 * VS) = (rv0.w >> 16) | (rv1.w & 0xffff0000u);
    };
    __syncthreads();
    gload(0);
    lstore(0);
    __syncthreads();
    const int ntile = nkeys >> 6;
    for (int kt = 0; kt < ntile; ++kt) {
      const int cur = kt & 1;
      const bool more = (kt + 1 < ntile);
      if (more) gload((kt + 1) * 64);
      __builtin_amdgcn_sched_barrier(0);
      f32x16 st[2];
#pragma unroll
      for (int e = 0; e < 16; ++e) { st[0][e] = 0.f; st[1][e] = 0.f; }
      const bfu* kb_ = Ksm + cur * KBUF + l31 * KS + 8 * hh;
#pragma unroll
      for (int kb = 0; kb < 2; ++kb)
#pragma unroll
        for (int ks = 0; ks < NKS; ++ks) {
          bf16x8 a = *(const bf16x8*)(kb_ + kb * 32 * KS + ks * 16);
          st[kb] = __builtin_amdgcn_mfma_f32_32x32x16_bf16(a, qf[ks], st[kb], 0, 0, 0);
        }
      float mx = st[0][0];
#pragma unroll
      for (int e = 0; e < 16; ++e) { mx = fmaxf(mx, st[0][e]); mx = fmaxf(mx, st[1][e]); }
      mx = fmaxf(mx, __shfl_xor(mx, 32));
      const float cand = mx * sc;
      if (__builtin_amdgcn_ballot_w64(cand > mrun + 8.f) != 0) {
        const float mnew = fmaxf(mrun, cand);
        const float alpha = __builtin_amdgcn_exp2f(mrun - mnew);
        lrun *= alpha;
#pragma unroll
        for (int e = 0; e < 16; ++e) { ot[0][e] *= alpha; ot[1][e] *= alpha; }
        mrun = mnew;
      }
      {
        const hwf2 sc2 = {sc, sc}, mn2 = {mrun, mrun};
        hwf2 ls2 = {0.f, 0.f};
#pragma unroll
        for (int e = 0; e < 16; e += 2) {
          hwf2 t0 = {st[0][e], st[0][e + 1]}, t1 = {st[1][e], st[1][e + 1]};
          t0 = t0 * sc2 - mn2; t1 = t1 * sc2 - mn2;
          t0.x = __builtin_amdgcn_exp2f(t0.x); t0.y = __builtin_amdgcn_exp2f(t0.y);
          t1.x = __builtin_amdgcn_exp2f(t1.x); t1.y = __builtin_amdgcn_exp2f(t1.y);
          st[0][e] = t0.x; st[0][e + 1] = t0.y; st[1][e] = t1.x; st[1][e + 1] = t1.y;
          ls2 += t0; ls2 += t1;
        }
        lrun += ls2.x + ls2.y;
      }
      const bfu* vb_ = Vsm + cur * VBUF + l31 * VS + 4 * hh;
#pragma unroll
      for (int kb = 0; kb < 2; ++kb)
#pragma unroll
        for (int s = 0; s < 2; ++s) {
          uint4 pb;
          pb.x = pack2(st[kb][8 * s + 0], st[kb][8 * s + 1]);
          pb.y = pack2(st[kb][8 * s + 2], st[kb][8 * s + 3]);
          pb.z = pack2(st[kb][8 * s + 4], st[kb][8 * s + 5]);
          pb.w = pack2(st[kb][8 * s + 6], st[kb][8 * s + 7]);
          const bf16x8 bfr = __builtin_bit_cast(bf16x8, pb);
#pragma unroll
          for (int db = 0; db < 2; ++db) {
            const bfu* va = vb_ + db * 32 * VS + kb * 32 + 16 * s;
            const uint2 lo = *(const uint2*)va;
            const uint2 hi = *(const uint2*)(va + 8);
            const uint4 au = make_uint4(lo.x, lo.y, hi.x, hi.y);
            ot[db] = __builtin_amdgcn_mfma_f32_32x32x16_bf16(__builtin_bit_cast(bf16x8, au), bfr, ot[db], 0, 0, 0);
          }
        }
      if (more) lstore(cur ^ 1);
      __syncthreads();
    }
    const float ltot = lrun + __shfl_xor(lrun, 32);
    const float inv = 1.f / ltot;
    bfu* op = O + (size_t)(qrow + l31) * D + hq * 64 + 4 * hh;
#pragma unroll
    for (int db = 0; db < 2; ++db)
#pragma unroll
      for (int g = 0; g < 4; ++g) {
        uint2 w;
        w.x = pack2(ot[db][4 * g] * inv, ot[db][4 * g + 1] * inv);
        w.y = pack2(ot[db][4 * g + 2] * inv, ot[db][4 * g + 3] * inv);
        *(uint2*)(op + db * 32 + 8 * g) = w;
      }
  }
}

DEVI float fast_softplus(float x) { return fmaxf(x, 0.f) + __logf(1.f + __expf(-fabsf(x))); }

typedef float f2 __attribute__((ext_vector_type(2)));
struct StepVec {
  f2 a[4], w[4], b[4], k[4], r[4];
  float v0, v1;
  DEVI void load(const float* sw, const float* sk, const float* sa, const float* sb, const float* sr, const float* sv,
                 int s, int sq, int ri) {
    const int o = s * 64 + sq * 8;
    const float4 a0 = *(const float4*)(sa + o), a1 = *(const float4*)(sa + o + 4);
    const float4 w0 = *(const float4*)(sw + o), w1 = *(const float4*)(sw + o + 4);
    const float4 b0 = *(const float4*)(sb + o), b1 = *(const float4*)(sb + o + 4);
    const float4 k0 = *(const float4*)(sk + o), k1 = *(const float4*)(sk + o + 4);
    const float4 r0 = *(const float4*)(sr + o), r1 = *(const float4*)(sr + o + 4);
    a[0] = f2{a0.x, a0.y}; a[1] = f2{a0.z, a0.w}; a[2] = f2{a1.x, a1.y}; a[3] = f2{a1.z, a1.w};
    w[0] = f2{w0.x, w0.y}; w[1] = f2{w0.z, w0.w}; w[2] = f2{w1.x, w1.y}; w[3] = f2{w1.z, w1.w};
    b[0] = f2{b0.x, b0.y}; b[1] = f2{b0.z, b0.w}; b[2] = f2{b1.x, b1.y}; b[3] = f2{b1.z, b1.w};
    k[0] = f2{k0.x, k0.y}; k[1] = f2{k0.z, k0.w}; k[2] = f2{k1.x, k1.y}; k[3] = f2{k1.z, k1.w};
    r[0] = f2{r0.x, r0.y}; r[1] = f2{r0.z, r0.w}; r[2] = f2{r1.x, r1.y}; r[3] = f2{r1.z, r1.w};
    const float2 vv = *(const float2*)(sv + s * 64 + ri);
    v0 = vv.x; v1 = vv.y;
  }
};
DEVI void rwkv_step(const StepVec& x, f2 (&S0)[4], f2 (&S1)[4], float* ydst, int sq) {
  f2 d0 = S0[0] * x.a[0], d1 = S1[0] * x.a[0];
#pragma unroll
  for (int e = 1; e < 4; ++e) { d0 += S0[e] * x.a[e]; d1 += S1[e] * x.a[e]; }
  const float dot0 = sum8(d0.x + d0.y), dot1 = sum8(d1.x + d1.y);
  const f2 dd0 = f2{dot0, dot0}, dd1 = f2{dot1, dot1};
  const f2 vv0 = f2{x.v0, x.v0}, vv1 = f2{x.v1, x.v1};
#pragma unroll
  for (int e = 0; e < 4; ++e) {
    S0[e] = S0[e] * x.w[e] + (dd0 * x.b[e] + vv0 * x.k[e]);
    S1[e] = S1[e] * x.w[e] + (dd1 * x.b[e] + vv1 * x.k[e]);
  }
  f2 y0 = S0[0] * x.r[0], y1 = S1[0] * x.r[0];
#pragma unroll
  for (int e = 1; e < 4; ++e) { y0 += S0[e] * x.r[e]; y1 += S1[e] * x.r[e]; }
  const float ys0 = sum8(y0.x + y0.y), ys1 = sum8(y1.x + y1.y);
  if (sq == 0) *(float2*)ydst = make_float2(ys0, ys1);
}

DEVI void rwkv_scan(const Params& p, unsigned char* smem) {
  float* sw = (float*)smem;
  float* sk = sw + 2048;
  float* sa = sk + 2048;
  float* sb = sa + 2048;
  float* sr = sb + 2048;
  float* sv = sr + 2048;
  float* sy = sv + 2048;
  const int tid = threadIdx.x, lane = tid & 63, wave = tid >> 6, l31 = lane & 31, hh = lane >> 5;
  const bfu* R = (const bfu*)(p.ws + OFF_BIG);
  const bfu* Kb = (const bfu*)(p.ws + OFF_BIG + SLOT);
  const bfu* Vb = (const bfu*)(p.ws + OFF_BIG + 2 * SLOT);
  const bfu* TW = (const bfu*)(p.ws + OFF_TW);
  const bfu* AA = (const bfu*)(p.ws + OFF_AA);
  const bfu* Wt = (const bfu*)(p.ws + OFF_W);
  float* BON = (float*)(p.ws + OFF_BON);
  const int qn = wave >> 1, cb = wave & 1;
  for (int it = blockIdx.x; it < 256; it += gridDim.x) {
    const int dir = it >> 7, b = (it >> 4) & 7, h = it & 15;
    bfu* Y = (bfu*)(p.ws + (dir ? OFF_EX : OFF_U));
    const int ch = h * 64 + lane;
    const float kkc = p.in[27][ch], kac = p.in[28][ch], rkc = p.in[29][ch];
    const int chm = h * 64 + cb * 32 + l31;
    const float bias_m = qn ? p.in[22][dir * 1024 + chm] : p.in[19][dir * 1024 + chm];
    bf16x8 bfr[4];
    {
      const bfu* wp = Wt + (qn ? A2T : W2T) + dir * 65536 + (size_t)chm * 64 + 8 * hh;
#pragma unroll
      for (int ks = 0; ks < 4; ++ks) bfr[ks] = *(const bf16x8*)(wp + ks * 16);
    }
    const bfu* LA = qn ? AA : TW;
    const int sq = lane & 7, ri = wave * 16 + (lane >> 3) * 2;
    f2 S0[4], S1[4];
#pragma unroll
    for (int e = 0; e < 4; ++e) { S0[e] = f2{0.f, 0.f}; S1[e] = f2{0.f, 0.f}; }
    bf16x8 afr[4];
    unsigned short pk_[8], pv_[8], pr_[8];
    auto tokbase = [&](int c, int& jbase, int& jstep) {
      const int p0 = c * 32;
      jbase = dir ? ((p0 < CL) ? (CL - 1 - p0) : (TT + CL - 1 - p0)) : p0;
      jstep = dir ? -1 : 1;
    };
    auto prefetch = [&](int c) {
      int jbase, jstep;
      tokbase(c, jbase, jstep);
      {
        const size_t row = (size_t)b * TT + (jbase + jstep * l31);
        const bfu* ap = LA + row * 128 + dir * 64 + 8 * hh;
#pragma unroll
        for (int ks = 0; ks < 4; ++ks) afr[ks] = *(const bf16x8*)(ap + ks * 16);
      }
#pragma unroll
      for (int i = 0; i < 8; ++i) {
        const int s = wave + 4 * i;
        const size_t off = ((size_t)b * TT + (jbase + jstep * s)) * D + ch;
        pk_[i] = Kb[off]; pv_[i] = Vb[off]; pr_[i] = R[off];
      }
    };
    __syncthreads();
    prefetch(0);
    for (int c = 0; c < 72; ++c) {
      int jbase, jstep;
      tokbase(c, jbase, jstep);
      {
        f32x16 acc;
#pragma unroll
        for (int e = 0; e < 16; ++e) acc[e] = 0.f;
#pragma unroll
        for (int ks = 0; ks < 4; ++ks) acc = __builtin_amdgcn_mfma_f32_32x32x16_bf16(afr[ks], bfr[ks], acc, 0, 0, 0);
        float* dst = (qn ? sb : sw) + cb * 32 + l31;
#pragma unroll
        for (int r = 0; r < 16; ++r) {
          const int step = (r & 3) + 8 * (r >> 2) + 4 * hh;
          const float x = acc[r] + bias_m;
          float o;
          if (qn) o = 1.f / (1.f + __expf(-x));
          else o = __expf(-0.60653066f / (1.f + __expf(-x)));
          dst[step * 64] = o;
        }
      }
      __syncthreads();
#pragma unroll
      for (int i = 0; i < 8; ++i) {
        const int s = wave + 4 * i;
        const float av = sb[s * 64 + lane];
        const float kv = bf2f(pk_[i]), vv = bf2f(pv_[i]), rv = bf2f(pr_[i]);
        const float kdir = kv * (1.f + (av - 1.f) * kac);
        const float kkraw = kv * kkc;
        const float kk = kkraw * rsqrtf(fmaxf(wave_sum(kkraw * kkraw), 1e-24f));
        const float bon = wave_sum(rv * kdir * rkc);
        if (lane == 0) BON[((size_t)dir * M + (size_t)b * TT + (jbase + jstep * s)) * 16 + h] = bon;
        sk[s * 64 + lane] = kdir;
        sa[s * 64 + lane] = -kk;
        sb[s * 64 + lane] = kk * av;
        sr[s * 64 + lane] = rv;
        sv[s * 64 + lane] = vv;
      }
      __syncthreads();
      if (c + 1 < 72) prefetch(c + 1);
      StepVec va, vb;
      va.load(sw, sk, sa, sb, sr, sv, 0, sq, ri);
#pragma unroll 1
      for (int s = 0; s < 32; s += 2) {
        vb.load(sw, sk, sa, sb, sr, sv, s + 1, sq, ri);
        rwkv_step(va, S0, S1, sy + s * 64 + ri, sq);
        if (s + 2 < 32) va.load(sw, sk, sa, sb, sr, sv, s + 2, sq, ri);
        rwkv_step(vb, S0, S1, sy + (s + 1) * 64 + ri, sq);
      }
      __syncthreads();
      {
        const int s = tid >> 3, sg = tid & 7;
        const size_t row = (size_t)b * TT + (jbase + jstep * s);
        float f[8];
#pragma unroll
        for (int e = 0; e < 8; ++e) f[e] = sy[s * 64 + sg * 8 + e];
        *(uint4*)(Y + row * D + h * 64 + sg * 8) = pack8(f);
      }
    }
    __syncthreads();
  }
}

DEVI void rwkv_post(const Params& p) {
  const bfu* Y0 = (const bfu*)(p.ws + OFF_U);
  const bfu* Y1 = (const bfu*)(p.ws + OFF_EX);
  const bfu* Vb = (const bfu*)(p.ws + OFF_BIG + 2 * SLOT);
  const bfu* G = (const bfu*)(p.ws + OFF_BIG + 3 * SLOT);
  const float* BON = (const float*)(p.ws + OFF_BON);
  bfu* A = (bfu*)(p.ws + OFF_BIG);
  const float* lnw = p.in[30];
  const float* lnb = p.in[31];
  const int total = M * 64;
  for (int idx = blockIdx.x * NTHR + threadIdx.x; idx < total; idx += gridDim.x * NTHR) {
    const int row = idx >> 6, rem = idx & 63;
    const int h = rem >> 2, sg = rem & 3;
    const size_t off = (size_t)row * D + h * 64 + sg * 16;
    float y[16], t[16];
    unpack8(*(const uint4*)(Y0 + off), y); unpack8(*(const uint4*)(Y0 + off + 8), y + 8);
    unpack8(*(const uint4*)(Y1 + off), t); unpack8(*(const uint4*)(Y1 + off + 8), t + 8);
    float s = 0.f;
#pragma unroll
    for (int e = 0; e < 16; ++e) { y[e] += t[e]; s += y[e]; }
    s = sum4(s);
    const float mean = s * (1.f / 64.f);
    float vs = 0.f;
#pragma unroll
    for (int e = 0; e < 16; ++e) { const float d = y[e] - mean; vs += d * d; }
    vs = sum4(vs);
    const float rinv = rsqrtf(vs * (1.f / 64.f) + 64e-5f);
    const float bon = BON[(size_t)row * 16 + h] + BON[((size_t)M + row) * 16 + h];
    float vv[16], gg[16], o[16];
    unpack8(*(const uint4*)(Vb + off), vv); unpack8(*(const uint4*)(Vb + off + 8), vv + 8);
    unpack8(*(const uint4*)(G + off), gg); unpack8(*(const uint4*)(G + off + 8), gg + 8);
    const int c0 = h * 64 + sg * 16;
#pragma unroll
    for (int e = 0; e < 16; ++e) {
      const float yn = (y[e] - mean) * rinv * lnw[c0 + e] + lnb[c0 + e] + bon * vv[e];
      o[e] = yn * gg[e];
    }
    store16bf(A + off, o);
  }
}

DEVI void gla_scan(const Params& p, unsigned char* smem) {
  constexpr int QS = 136, TS = 72;
  bfu* Ql = (bfu*)smem;
  bfu* Kl = Ql + 64 * QS;
  bfu* KeT = Kl + 64 * QS;
  bfu* Vt = KeT + 128 * TS;
  bfu* Att = Vt + 64 * TS;
  float* sgd = (float*)Att;
  float* tot = (float*)(Att + 64 * TS);
  float* ebl = tot + 512;
  const int tid = threadIdx.x, lane = tid & 63, wave = tid >> 6, l15 = lane & 15, g4 = lane >> 4;
  const bfu* GQ = (const bfu*)(p.ws + OFF_BIG);
  const bfu* GK = GQ + (size_t)M * 512;
  const bfu* GV = (const bfu*)(p.ws + OFF_BIG + SLOT);
  const float* GD = (const float*)(p.ws + OFF_GD);
  const float* gup = p.in[53];
  const float* gbias = p.in[54];
  for (int it = blockIdx.x; it < 256; it += gridDim.x) {
    const int dir = it >> 7, b = (it >> 4) & 7, h = (it >> 2) & 3, vs = it & 3;
    bfu* O = (bfu*)(p.ws + (dir ? OFF_EX : OFF_BIG + 3 * SLOT));
    const int kp = lane;
    float gu0[16], gu1[16];
#pragma unroll
    for (int r = 0; r < 16; ++r) {
      const float2 t = *(const float2*)(gup + (dir * 16 + r) * 512 + h * 128 + 2 * kp);
      gu0[r] = t.x; gu1[r] = t.y;
    }
    const float2 gbv = *(const float2*)(gbias + dir * 512 + h * 128 + 2 * kp);
    f32x4 S[8];
#pragma unroll
    for (int i = 0; i < 8; ++i) S[i] = f32x4{0.f, 0.f, 0.f, 0.f};
    uint4 pq0, pq1, pq2, pq3, pk0, pk1, pk2, pk3, pv0, pv1;
    float4 pgd;
    auto tokbase = [&](int c, int& jbase, int& jstep) {
      const int p0 = c * 64;
      jbase = dir ? ((p0 < CL) ? (CL - 1 - p0) : (TT + CL - 1 - p0)) : p0;
      jstep = dir ? -1 : 1;
    };
    const int ls = tid >> 4, lkc = (tid & 15) * 8;
    const int vsp = tid & 31, vseg = tid >> 5;
#define GLA_PREFETCH(CC) do { \
      int jb_, js_; tokbase((CC), jb_, js_); \
      const size_t ra_ = (size_t)b * TT + (jb_ + js_ * (ls)); \
      const size_t rb_ = (size_t)b * TT + (jb_ + js_ * (ls + 16)); \
      const size_t rc_ = (size_t)b * TT + (jb_ + js_ * (ls + 32)); \
      const size_t rd_ = (size_t)b * TT + (jb_ + js_ * (ls + 48)); \
      pq0 = *(const uint4*)(GQ + ra_ * 512 + h * 128 + lkc); pk0 = *(const uint4*)(GK + ra_ * 512 + h * 128 + lkc); \
      pq1 = *(const uint4*)(GQ + rb_ * 512 + h * 128 + lkc); pk1 = *(const uint4*)(GK + rb_ * 512 + h * 128 + lkc); \
      pq2 = *(const uint4*)(GQ + rc_ * 512 + h * 128 + lkc); pk2 = *(const uint4*)(GK + rc_ * 512 + h * 128 + lkc); \
      pq3 = *(const uint4*)(GQ + rd_ * 512 + h * 128 + lkc); pk3 = *(const uint4*)(GK + rd_ * 512 + h * 128 + lkc); \
      const size_t r0_ = (size_t)b * TT + (jb_ + js_ * (2 * vsp)); \
      const size_t r1_ = (size_t)b * TT + (jb_ + js_ * (2 * vsp + 1)); \
      pv0 = *(const uint4*)(GV + r0_ * D + h * 256 + vs * 64 + vseg * 8); \
      pv1 = *(const uint4*)(GV + r1_ * D + h * 256 + vs * 64 + vseg * 8); \
      const size_t rg_ = (size_t)b * TT + (jb_ + js_ * (tid >> 2)); \
      pgd = *(const float4*)(GD + rg_ * 32 + dir * 16 + (tid & 3) * 4); \
    } while (0)
    __syncthreads();
    GLA_PREFETCH(0);
    for (int c = 0; c < 36; ++c) {
      int jbase, jstep;
      tokbase(c, jbase, jstep);
      *(uint4*)(Ql + (ls) * QS + lkc) = pq0; *(uint4*)(Kl + (ls) * QS + lkc) = pk0;
      *(uint4*)(Ql + (ls + 16) * QS + lkc) = pq1; *(uint4*)(Kl + (ls + 16) * QS + lkc) = pk1;
      *(uint4*)(Ql + (ls + 32) * QS + lkc) = pq2; *(uint4*)(Kl + (ls + 32) * QS + lkc) = pk2;
      *(uint4*)(Ql + (ls + 48) * QS + lkc) = pq3; *(uint4*)(Kl + (ls + 48) * QS + lkc) = pk3;
      {
        bfu* vb = Vt + (vseg * 8) * TS + 2 * vsp;
        *(unsigned*)(vb + 0 * TS) = (pv0.x & 0xffffu) | (pv1.x << 16);
        *(unsigned*)(vb + 1 * TS) = (pv0.x >> 16) | (pv1.x & 0xffff0000u);
        *(unsigned*)(vb + 2 * TS) = (pv0.y & 0xffffu) | (pv1.y << 16);
        *(unsigned*)(vb + 3 * TS) = (pv0.y >> 16) | (pv1.y & 0xffff0000u);
        *(unsigned*)(vb + 4 * TS) = (pv0.z & 0xffffu) | (pv1.z << 16);
        *(unsigned*)(vb + 5 * TS) = (pv0.z >> 16) | (pv1.z & 0xffff0000u);
        *(unsigned*)(vb + 6 * TS) = (pv0.w & 0xffffu) | (pv1.w << 16);
        *(unsigned*)(vb + 7 * TS) = (pv0.w >> 16) | (pv1.w & 0xffff0000u);
        *(float4*)(sgd + (tid >> 2) * 16 + (tid & 3) * 4) = pgd;
      }
      __syncthreads();
      if (c + 1 < 36) GLA_PREFETCH(c + 1);
      float al0[16], al1[16];
      float pr0 = 1.f, pr1 = 1.f;
#pragma unroll
      for (int i = 0; i < 16; ++i) {
        const float4* gd = (const float4*)(sgd + (wave * 16 + i) * 16);
        float x0 = gbv.x, x1 = gbv.y;
#pragma unroll
        for (int q4 = 0; q4 < 4; ++q4) {
          const float4 t = gd[q4];
          x0 += t.x * gu0[4 * q4] + t.y * gu0[4 * q4 + 1] + t.z * gu0[4 * q4 + 2] + t.w * gu0[4 * q4 + 3];
          x1 += t.x * gu1[4 * q4] + t.y * gu1[4 * q4 + 1] + t.z * gu1[4 * q4 + 2] + t.w * gu1[4 * q4 + 3];
        }
        al0[i] = __expf(-fast_softplus(-x0) * (1.f / 16.f));
        al1[i] = __expf(-fast_softplus(-x1) * (1.f / 16.f));
        pr0 *= al0[i]; pr1 *= al1[i];
      }
      *(float2*)(tot + wave * 128 + 2 * kp) = make_float2(pr0, pr1);
      __syncthreads();
      {
        float c0 = 1.f, c1 = 1.f, e0 = 1.f, e1 = 1.f;
#pragma unroll
        for (int w = 0; w < 4; ++w) {
          const float2 t = *(const float2*)(tot + w * 128 + 2 * kp);
          if (w < wave) { c0 *= t.x; c1 *= t.y; }
          e0 *= t.x; e1 *= t.y;
        }
        if (wave == 0) *(float2*)(ebl + 2 * kp) = make_float2(e0, e1);
        unsigned* d0 = (unsigned*)(KeT + (2 * kp) * TS + wave * 16);
        unsigned* d1 = (unsigned*)(KeT + (2 * kp + 1) * TS + wave * 16);
#pragma unroll
        for (int j = 0; j < 8; ++j) {
          unsigned short ka[2], kb2[2];
#pragma unroll
          for (int u = 0; u < 2; ++u) {
            const int i = 2 * j + u;
            const int s = wave * 16 + i;
            c0 *= al0[i]; c1 *= al1[i];
            const float i0 = __builtin_amdgcn_rcpf(c0), i1 = __builtin_amdgcn_rcpf(c1);
            unsigned* qp = (unsigned*)(Ql + s * QS + 2 * kp);
            unsigned* kq = (unsigned*)(Kl + s * QS + 2 * kp);
            const unsigned qw = *qp, kw = *kq;
            *qp = pack2(bflo(qw) * c0, bfhi(qw) * c1);
            const float k0 = bflo(kw), k1 = bfhi(kw);
            *kq = pack2(k0 * i0, k1 * i1);
            ka[u] = f2bf(k0 * (e0 * i0)); kb2[u] = f2bf(k1 * (e1 * i1));
          }
          d0[j] = (unsigned)ka[0] | ((unsigned)ka[1] << 16);
          d1[j] = (unsigned)kb2[0] | ((unsigned)kb2[1] << 16);
        }
      }
      __syncthreads();
      const bool want_o = (c >= 4);
      if (want_o) {
        f32x4 at[4];
#pragma unroll
        for (int sb = 0; sb < 4; ++sb) at[sb] = f32x4{0.f, 0.f, 0.f, 0.f};
#pragma unroll
        for (int ks = 0; ks < 4; ++ks) {
          const bf16x8 a = *(const bf16x8*)(Ql + (wave * 16 + l15) * QS + ks * 32 + g4 * 8);
#pragma unroll
          for (int sb = 0; sb < 4; ++sb) {
            const bf16x8 bb = *(const bf16x8*)(Kl + (sb * 16 + l15) * QS + ks * 32 + g4 * 8);
            at[sb] = __builtin_amdgcn_mfma_f32_16x16x32_bf16(a, bb, at[sb], 0, 0, 0);
          }
        }
#pragma unroll
        for (int sb = 0; sb < 4; ++sb)
#pragma unroll
          for (int r = 0; r < 4; ++r) {
            const int t = wave * 16 + g4 * 4 + r, s = sb * 16 + l15;
            Att[t * TS + s] = f2bf((s <= t) ? at[sb][r] : 0.f);
          }
      }
      __syncthreads();
      {
        bf16x8 sf[4];
#pragma unroll
        for (int ks = 0; ks < 4; ++ks) {
          uint4 u;
          u.x = pack2(S[2 * ks][0], S[2 * ks][1]); u.y = pack2(S[2 * ks][2], S[2 * ks][3]);
          u.z = pack2(S[2 * ks + 1][0], S[2 * ks + 1][1]); u.w = pack2(S[2 * ks + 1][2], S[2 * ks + 1][3]);
          sf[ks] = __builtin_bit_cast(bf16x8, u);
        }
        bf16x8 vf[2];
#pragma unroll
        for (int k2 = 0; k2 < 2; ++k2) vf[k2] = *(const bf16x8*)(Vt + (wave * 16 + l15) * TS + k2 * 32 + g4 * 8);
        if (want_o)
#pragma unroll
        for (int tb = 0; tb < 4; ++tb) {
          f32x4 o = f32x4{0.f, 0.f, 0.f, 0.f};
#pragma unroll
          for (int ks = 0; ks < 4; ++ks) {
            const bfu* qa = Ql + (tb * 16 + l15) * QS + ks * 32 + g4 * 4;
            const uint2 lo = *(const uint2*)qa;
            const uint2 hi = *(const uint2*)(qa + 16);
            const uint4 au = make_uint4(lo.x, lo.y, hi.x, hi.y);
            o = __builtin_amdgcn_mfma_f32_16x16x32_bf16(__builtin_bit_cast(bf16x8, au), sf[ks], o, 0, 0, 0);
          }
#pragma unroll
          for (int k2 = 0; k2 < 2; ++k2) {
            const bf16x8 a = *(const bf16x8*)(Att + (tb * 16 + l15) * TS + k2 * 32 + g4 * 8);
            o = __builtin_amdgcn_mfma_f32_16x16x32_bf16(a, vf[k2], o, 0, 0, 0);
          }
#pragma unroll
          for (int r = 0; r < 4; ++r) {
            const int t = tb * 16 + g4 * 4 + r;
            const size_t row = (size_t)b * TT + (jbase + jstep * t);
            O[row * D + h * 256 + vs * 64 + wave * 16 + l15] = f2bf(o[r]);
          }
        }
#pragma unroll
        for (int kb = 0; kb < 8; ++kb) {
          const float4 e = *(const float4*)(ebl + kb * 16 + g4 * 4);
          S[kb][0] *= e.x; S[kb][1] *= e.y; S[kb][2] *= e.z; S[kb][3] *= e.w;
#pragma unroll
          for (int k2 = 0; k2 < 2; ++k2) {
            const bf16x8 a = *(const bf16x8*)(KeT + (kb * 16 + l15) * TS + k2 * 32 + g4 * 8);
            S[kb] = __builtin_amdgcn_mfma_f32_16x16x32_bf16(a, vf[k2], S[kb], 0, 0, 0);
          }
        }
      }
      __syncthreads();
    }
  }
}

DEVI void gla_post(const Params& p) {
  const bfu* O0 = (const bfu*)(p.ws + OFF_BIG + 3 * SLOT);
  const bfu* O1 = (const bfu*)(p.ws + OFF_EX);
  const bfu* GO = (const bfu*)(p.ws + OFF_BIG + 2 * SLOT);
  bfu* A = (bfu*)(p.ws + OFF_BIG);
  const float* og = p.in[55];
  const int total = M * 64;
  for (int idx = blockIdx.x * NTHR + threadIdx.x; idx < total; idx += gridDim.x * NTHR) {
    const int row = idx >> 6, rem = idx & 63;
    if (row % TT < CL) continue;
    const int h = rem >> 4, sg = rem & 15;
    const size_t off = (size_t)row * D + h * 256 + sg * 16;
    float y[16], t[16];
    unpack8(*(const uint4*)(O0 + off), y); unpack8(*(const uint4*)(O0 + off + 8), y + 8);
    unpack8(*(const uint4*)(O1 + off), t); unpack8(*(const uint4*)(O1 + off + 8), t + 8);
    float s = 0.f;
#pragma unroll
    for (int e = 0; e < 16; ++e) { y[e] += t[e]; s += y[e] * y[e]; }
    s = sum16(s);
    const float rinv = rsqrtf(s * (1.f / 256.f) + 1e-6f);
    float gg[16], o[16];
    unpack8(*(const uint4*)(GO + off), gg); unpack8(*(const uint4*)(GO + off + 8), gg + 8);
#pragma unroll
    for (int e = 0; e < 16; ++e) {
      const float g = gg[e];
      o[e] = y[e] * rinv * og[sg * 16 + e] * (g * sigmoidf_(g));
    }
    store16bf(A + off, o);
  }
}

DEVI void init_phase(const Params& p, unsigned char* smem) {
  const int tid = threadIdx.x;
  const int nconv = conv_total_units(0);
  const int n_mod = 384, n_copy = 0, n_rope = 384;
  const int total = n_mod + nconv + n_copy + n_rope;
  float* fs = (float*)smem;
  for (int it = blockIdx.x; it < total; it += gridDim.x) {
    if (it < n_mod) {
      const int l = it / 96, n = (it - l * 96) * 64 + (tid & 63);
      const int wv = tid >> 6;
      __syncthreads();
      for (int i = tid; i < 9 * 1024; i += NTHR) {
        const int m = i >> 10, k = i & 1023;
        const float c = (m < 8) ? p.in[1][m * 1024 + k] : p.in[3][k];
        fs[i] = c / (1.f + __expf(-c));
      }
      __syncthreads();
      const float* aw = p.in[4 + (l == 0 ? 0 : l == 1 ? 10 : l == 2 ? 32 : 44)];
      const float* ab = p.in[5 + (l == 0 ? 0 : l == 1 ? 10 : l == 2 ? 32 : 44)];
      float acc[9];
#pragma unroll
      for (int m = 0; m < 9; ++m) acc[m] = 0.f;
      for (int k = wv * 256; k < wv * 256 + 256; k += 4) {
        const float w0 = aw[(size_t)k * 6144 + n], w1 = aw[(size_t)(k + 1) * 6144 + n];
        const float w2 = aw[(size_t)(k + 2) * 6144 + n], w3 = aw[(size_t)(k + 3) * 6144 + n];
#pragma unroll
        for (int m = 0; m < 9; ++m) {
          const float4 s = *(const float4*)(fs + m * 1024 + k);
          acc[m] += s.x * w0 + s.y * w1 + s.z * w2 + s.w * w3;
        }
      }
      float* red = fs + 9 * 1024;
#pragma unroll
      for (int m = 0; m < 9; ++m) red[(wv * 9 + m) * 64 + (tid & 63)] = acc[m];
      __syncthreads();
      if (wv == 0) {
        float* mod = (float*)(p.ws + OFF_MOD) + (size_t)l * 9 * 6144;
        const float bias = ab[n];
#pragma unroll
        for (int m = 0; m < 9; ++m)
          mod[m * 6144 + n] = red[m * 64 + tid] + red[(9 + m) * 64 + tid] + red[(18 + m) * 64 + tid] + red[(27 + m) * 64 + tid] + bias;
      }
      __syncthreads();
    } else if (it < n_mod + nconv) {
      conv_do(p, 0, it - n_mod, fs);
    } else if (it < n_mod + nconv + n_copy) {
      const int r0 = (it - n_mod - nconv) * 8;
      float* xr = (float*)(p.ws + OFF_XR);
#pragma unroll
      for (int i = 0; i < 8; ++i) {
        const int row = r0 + i;
        const int b = row / TT, j = row - b * TT;
        const float* src = (j < CL) ? (p.in[2] + ((size_t)b * CL + j) * D) : (p.in[0] + ((size_t)b * 2048 + (j - CL)) * D);
        *(float4*)(xr + (size_t)row * D + tid * 4) = *(const float4*)(src + tid * 4);
      }
    } else {
      const int e = (it - n_mod - nconv - n_copy) * 256 + tid;
      if (e < 2048 * 32) {
        const int t = e >> 5, i = e & 31;
        const int f = i & 15;
        const float inv = powf(10000.f, -(float)f / 16.f);
        const float pos = (i < 16) ? (float)(t >> 6) : (float)(t & 63);
        const float ang = pos * inv;
        float* ra = (float*)(p.ws + OFF_ROPEA);
        ra[e] = cosf(ang);
        ra[2048 * 32 + e] = sinf(ang);
      } else {
        const int e2 = e - 2048 * 32;
        const int t = e2 >> 4, i = e2 & 15;
        const int f = i & 7;
        const float inv = powf(10000.f, -(float)f / 8.f);
        const float pos = (i < 8) ? (float)(t >> 6) : (float)(t & 63);
        const float ang = pos * inv;
        float* rc = (float*)(p.ws + OFF_ROPEC);
        rc[e2] = cosf(ang);
        rc[2048 * 16 + e2] = sinf(ang);
      }
    }
  }
}

DEVI void norm_phase(const Params& p, unsigned char* smem, int layer, int which, int conv_layer, bool skip_ctx,
                     int fix_layer = -1, int fix_chunk = 0) {
  const int nconv = (conv_layer >= 0) ? conv_total_units(conv_layer) : 0;
  const int total = nconv + M / 8;
  if (gridDim.x != 512) fix_layer = -1;
  for (int it = blockIdx.x; it < total; it += gridDim.x) {
    if (it < nconv) conv_do(p, conv_layer, it, (float*)smem);
    else norm_rows(p, layer, which, it - nconv, skip_ctx, fix_layer, fix_chunk);
  }
}

struct EpiPartial {
  float* P; int q;
  DEVI void operator()(int row, int col, float (&v)[16]) const {
    const int mt = row >> 7, x = mt / 18, ml = mt - x * 18;
    const int lrow = (x * 2 + (ml - 16)) * 128 + (row & 127);
    float* d = P + ((size_t)q * 2048 + lrow) * D + col;
#pragma unroll
    for (int i = 0; i < 4; ++i) *(float4*)(d + 4 * i) = make_float4(v[4 * i], v[4 * i + 1], v[4 * i + 2], v[4 * i + 3]);
  }
};
struct EpiRes {
  float* xr; const float* mod; int chunk;
  DEVI void operator()(int row, int col, float (&v)[16]) const {
    const int b = row / TT, j = row - b * TT;
    const int midx = (j < CL) ? 8 : b;
    const float* g = mod + (size_t)midx * 6144 + chunk * 1024 + col;
    float* x = xr + (size_t)row * D + col;
#pragma unroll
    for (int q = 0; q < 4; ++q) {
      float4 xv = *(float4*)(x + 4 * q);
      const float4 gv = *(const float4*)(g + 4 * q);
      xv.x += gv.x * v[4 * q]; xv.y += gv.y * v[4 * q + 1]; xv.z += gv.z * v[4 * q + 2]; xv.w += gv.w * v[4 * q + 3];
      *(float4*)(x + 4 * q) = xv;
    }
  }
};

DEVI void res_gemm_phase(const Params& p, unsigned char* smem, int layer, int chunk, const bfu* A, int K, const bfu* W, bool skip_ctx) {
  float* xr = (float*)(p.ws + OFF_XR);
  const float* mod = (const float*)(p.ws + OFF_MOD) + (size_t)layer * 9 * 6144;
  EpiRes ep{xr, mod, chunk};
  if (skip_ctx || gridDim.x != 512) {
    gemm_phase(smem, [&](int) { return ALPlain{A, K}; }, W, K, 8, skip_ctx, ep);
    return;
  }
  const int4 xm = xmap_ref();
  const int xcd = xm.x, j = xm.y;
  for (int lt = j; lt < 128; lt += 64) {
    const int mt = xcd * 18 + (lt >> 3), nt = lt & 7;
    gemm_tile(smem, ALPlain{A, K}, W, K, K, mt * 128, nt * 128, ep);
  }
  {
    const int lt = 128 + (j >> 2), kq = j & 3, kl = K >> 2;
    EpiPartial epa{(float*)(p.ws + OFF_EX), kq};
    const int mt = xcd * 18 + (lt >> 3), nt = lt & 7;
    gemm_tile(smem, ALPlain{A + kq * kl, K}, W + kq * kl, K, kl, mt * 128, nt * 128, epa);
  }
}

DEVI void mlp_up_phase(const Params& p, unsigned char* smem, bool skip_ctx) {
  const bfu* U = (const bfu*)(p.ws + OFF_U);
  const bfu* W = (const bfu*)(p.ws + OFF_W) + WUP;
  bfu* H = (bfu*)(p.ws + OFF_BIG);
  gemm_phase(smem, [&](int) { return ALPlain{U, D}; }, W, 1024, 32, skip_ctx,
             [&](int row, int col, float (&v)[16]) {
#pragma unroll
               for (int e = 0; e < 16; ++e) { const float r = fmaxf(v[e], 0.f); v[e] = r * r; }
               store16bf(H + (size_t)row * 4096 + col, v);
             });
}
DEVI void mlp_down_phase(const Params& p, unsigned char* smem, int layer, bool skip_ctx) {
  res_gemm_phase(p, smem, layer, 5, (const bfu*)(p.ws + OFF_BIG), 4096, (const bfu*)(p.ws + OFF_W) + WDN, skip_ctx);
}
DEVI void out_phase(const Params& p, unsigned char* smem, int layer, const bfu* A, int woff, bool skip_ctx) {
  res_gemm_phase(p, smem, layer, 2, A, 1024, (const bfu*)(p.ws + OFF_W) + woff, skip_ctx);
}

#define PROBE_DUP(PH) 0
enum {
  PH_INIT = 0,
  PH_L0_NORM1, PH_L0_IN, PH_L0_ATT, PH_L0_OUT, PH_L0_NORM2, PH_L0_UP, PH_L0_DOWN,
  PH_L1_NORM1, PH_L1_MIX, PH_L1_IN, PH_L1_G, PH_L1_SCAN, PH_L1_POST, PH_L1_OUT, PH_L1_NORM2, PH_L1_UP, PH_L1_DOWN,
  PH_L2_NORM1, PH_L2_IN, PH_L2_QKV, PH_L2_ATT, PH_L2_OUT, PH_L2_NORM2, PH_L2_UP, PH_L2_DOWN,
  PH_L3_NORM1, PH_L3_IN, PH_L3_SCAN, PH_L3_POST, PH_L3_OUT, PH_L3_NORM2, PH_L3_UP, PH_L3_DOWN,
  PH_FINAL, NPHASES
};

template <int ph>
__device__ __forceinline__ void run_phase(const Params& p, unsigned char* smem) {
  const bfu* U = (const bfu*)(p.ws + OFF_U);
  const bfu* Wt = (const bfu*)(p.ws + OFF_W);
  unsigned char* big = p.ws + OFF_BIG;
  switch (ph) {
    case PH_INIT: init_phase(p, smem); break;
    case PH_L0_NORM1: norm_phase(p, smem, 0, 0, -1, false); break;
    case PH_L0_IN: {
      bfu* Q = (bfu*)big; bfu* Kb = (bfu*)(big + SLOT); bfu* Vb = Kb + (size_t)M * 256;
      const float* qg = p.in[8]; const float* kg = p.in[9];
      const float* cosA = (const float*)(p.ws + OFF_ROPEA); const float* sinA = cosA + 2048 * 32;
      gemm_phase(smem, [&](int) { return ALPlain{U, D}; }, Wt + WIN0, 1024, 12, false,
                 [&](int row, int col, float (&v)[16]) {
                   const int b = row / TT, j = row - b * TT;
                   if (col < 1280) {
                     float ss = 0.f;
#pragma unroll
                     for (int e = 0; e < 16; ++e) ss += v[e] * v[e];
                     ss = sum4(ss);
                     const float rinv = rsqrtf(ss * (1.f / 64.f) + 1e-6f);
                     const float* gain = (col < 1024) ? qg : kg;
                     const int e0 = col & 63;
#pragma unroll
                     for (int e = 0; e < 16; ++e) v[e] = v[e] * rinv * gain[e0 + e];
                     float pv[16];
#pragma unroll
                     for (int e = 0; e < 16; ++e) pv[e] = xor2(v[e]);
                     if (j >= CL) {
                       const int t = j - CL, sg = (col >> 4) & 3;
                       const float* cs = cosA + t * 32 + (sg & 1) * 16;
                       const float* sn = sinA + t * 32 + (sg & 1) * 16;
#pragma unroll
                       for (int e = 0; e < 16; ++e) {
                         const float c = cs[e], s = sn[e];
                         v[e] = (sg < 2) ? (v[e] * c - pv[e] * s) : (pv[e] * s + v[e] * c);
                       }
                     }
                     if (col < 1024) store16bf(Q + (size_t)row * D + col, v);
                     else store16bf(Kb + (size_t)row * 256 + (col - 1024), v);
                   } else {
                     store16bf(Vb + (size_t)row * 256 + (col - 1280), v);
                   }
                 });
    } break;
    case PH_L0_ATT: {
      bfu* Q = (bfu*)big; bfu* Kb = (bfu*)(big + SLOT); bfu* Vb = Kb + (size_t)M * 256;
      attn_mfma<0>(smem, Q, (bfu*)(big + 2 * SLOT), nullptr, Kb, 256, nullptr, Vb, 256, 0.125f * 1.4426950408889634f);
    } break;
    case PH_L0_OUT: out_phase(p, smem, 0, (const bfu*)(big + 2 * SLOT), WOUT0, false); break;
    case PH_L0_NORM2: norm_phase(p, smem, 0, 1, -1, false, 0, 2); break;
    case PH_L0_UP: mlp_up_phase(p, smem, false); break;
    case PH_L0_DOWN: mlp_down_phase(p, smem, 0, false); break;
    case PH_L1_NORM1: norm_phase(p, smem, 1, 0, 1, false, 0, 5); break;
    case PH_L1_MIX: {
      bfu* MK = (bfu*)(big + 3 * SLOT);
      bfu* MV = (bfu*)(p.ws + OFF_EX);
      bfu* MR = (bfu*)p.out;
      const float* mu0 = p.in[17];
      const float* mu2 = p.in[17] + 2 * 1024;
      const float* mu3 = p.in[17] + 3 * 1024;
      const int total = M * 64;
      for (int idx = blockIdx.x * NTHR + threadIdx.x; idx < total; idx += gridDim.x * NTHR) {
        const int row = idx >> 6, c0 = (idx & 63) * 16;
        const int j = row % TT;
        const bfu* pu = U + (size_t)row * D + c0;
        const bool hp = (j != 0 && j != CL), hn = (j != CL - 1 && j != TT - 1);
        const uint4 z = make_uint4(0, 0, 0, 0);
        float fc[16], fs[16], ok[16], ov[16], orr[16];
        {
          const uint4 c_0 = *(const uint4*)pu, c_1 = *(const uint4*)(pu + 8);
          const uint4 p_0 = hp ? *(const uint4*)(pu - D) : z, p_1 = hp ? *(const uint4*)(pu - D + 8) : z;
          const uint4 n_0 = hn ? *(const uint4*)(pu + D) : z, n_1 = hn ? *(const uint4*)(pu + D + 8) : z;
          float fp[16], fn[16];
          unpack8(c_0, fc); unpack8(c_1, fc + 8);
          unpack8(p_0, fp); unpack8(p_1, fp + 8);
          unpack8(n_0, fn); unpack8(n_1, fn + 8);
#pragma unroll
          for (int e = 0; e < 16; ++e) fs[e] = 0.5f * (fp[e] + fn[e]) - fc[e];
        }
#pragma unroll
        for (int q = 0; q < 4; ++q) {
          const float4 a = *(const float4*)(mu2 + c0 + 4 * q), bq = *(const float4*)(mu3 + c0 + 4 * q);
          const float4 r4 = *(const float4*)(mu0 + c0 + 4 * q);
          orr[4 * q] = fc[4 * q] + fs[4 * q] * r4.x; orr[4 * q + 1] = fc[4 * q + 1] + fs[4 * q + 1] * r4.y;
          orr[4 * q + 2] = fc[4 * q + 2] + fs[4 * q + 2] * r4.z; orr[4 * q + 3] = fc[4 * q + 3] + fs[4 * q + 3] * r4.w;
          ok[4 * q] = fc[4 * q] + fs[4 * q] * a.x; ok[4 * q + 1] = fc[4 * q + 1] + fs[4 * q + 1] * a.y;
          ok[4 * q + 2] = fc[4 * q + 2] + fs[4 * q + 2] * a.z; ok[4 * q + 3] = fc[4 * q + 3] + fs[4 * q + 3] * a.w;
          ov[4 * q] = fc[4 * q] + fs[4 * q] * bq.x; ov[4 * q + 1] = fc[4 * q + 1] + fs[4 * q + 1] * bq.y;
          ov[4 * q + 2] = fc[4 * q + 2] + fs[4 * q + 2] * bq.z; ov[4 * q + 3] = fc[4 * q + 3] + fs[4 * q + 3] * bq.w;
        }
        store16bf(MK + (size_t)row * D + c0, ok);
        store16bf(MV + (size_t)row * D + c0, ov);
        store16bf(MR + (size_t)row * D + c0, orr);
      }
    } break;
    case PH_L1_IN: {
      bfu* R = (bfu*)big;
      bfu* TW = (bfu*)(p.ws + OFF_TW); bfu* AA = (bfu*)(p.ws + OFF_AA); bfu* SG = (bfu*)(p.ws + OFF_SG);
      const float* mu = p.in[17];
      gemm_phase(smem,
                 [&](int nt) {
                   const int mi = (nt < 8) ? 0 : (nt < 16) ? 2 : (nt < 24) ? 3 : (nt == 24) ? 1 : (nt == 25) ? 4 : 5;
                   const bfu* pre = (nt < 8) ? (const bfu*)p.out
                                  : (nt < 16) ? (const bfu*)(big + 3 * SLOT)
                                  : (nt < 24) ? (const bfu*)(p.ws + OFF_EX) : nullptr;
                   return ALMix{U, mu + mi * 1024, pre};
                 },
                 Wt + W1CAT, 1024, 27, false,
                 [&](int row, int col, float (&v)[16]) {
                   if (col < 3072) {
                     const int which = col >> 10;
                     store16bf(R + (size_t)which * M * D + (size_t)row * D + (col & 1023), v);
                   } else if (col < 3200) {
#pragma unroll
                     for (int e = 0; e < 16; ++e) v[e] = tanhf(v[e]);
                     store16bf(TW + (size_t)row * 128 + (col - 3072), v);
                   } else if (col < 3328) {
                     store16bf(AA + (size_t)row * 128 + (col - 3200), v);
                   } else {
#pragma unroll
                     for (int e = 0; e < 16; ++e) v[e] = sigmoidf_(v[e]);
                     store16bf(SG + (size_t)row * 128 + (col - 3328), v);
                   }
                 });
    } break;
    case PH_L1_G: {
      const bfu* SG = (const bfu*)(p.ws + OFF_SG);
      bfu* G = (bfu*)(big + 3 * SLOT);
      gemm_phase(smem, [&](int) { return ALPlain{SG, 128}; }, Wt + G2T, 128, 8, false,
                 [&](int row, int col, float (&v)[16]) { store16bf(G + (size_t)row * D + col, v); });
    } break;
    case PH_L1_SCAN: rwkv_scan(p, smem); break;
    case PH_L1_POST: rwkv_post(p); break;
    case PH_L1_OUT: out_phase(p, smem, 1, (const bfu*)big, WOUT1, false); break;
    case PH_L1_NORM2: norm_phase(p, smem, 1, 1, -1, false, 1, 2); break;
    case PH_L1_UP: mlp_up_phase(p, smem, false); break;
    case PH_L1_DOWN: mlp_down_phase(p, smem, 1, false); break;
    case PH_L2_NORM1: norm_phase(p, smem, 2, 0, 2, false, 1, 5); break;
    case PH_L2_IN: {
      bfu* ZQ = (bfu*)big;
      bfu* ZKV = ZQ + (size_t)M * 512;
      bfu* KR = (bfu*)(p.ws + OFF_TW);
      float* SS = (float*)(p.ws + OFF_SS);
      const float* cosC = (const float*)(p.ws + OFF_ROPEC); const float* sinC = cosC + 2048 * 16;
      gemm_phase(smem, [&](int) { return ALPlain{U, D}; }, Wt + WIN2, 1024, 7, false,
                 [&](int row, int col, float (&v)[16]) {
                   const int b = row / TT, j = row - b * TT;
                   const int nt = col >> 7;
                   float ss = 0.f;
#pragma unroll
                   for (int e = 0; e < 16; ++e) ss += v[e] * v[e];
                   ss = sum8(ss);
                   float pv[16];
#pragma unroll
                   for (int e = 0; e < 16; ++e) pv[e] = xor1(v[e]);
                   if (nt < 6) {
                     if ((col & 127) == 0) SS[(size_t)row * 8 + nt] = ss;
                     if (nt < 4) store16bf(ZQ + (size_t)row * 512 + col, v);
                     else store16bf(ZKV + (size_t)row * 256 + (col - 512), v);
                   } else if (col < 800) {
                     const int sg = (col >> 4) & 1;
                     if (j >= CL) {
                       const int t = j - CL;
#pragma unroll
                       for (int e = 0; e < 16; ++e) {
                         const float c = cosC[t * 16 + e], s = sinC[t * 16 + e];
                         v[e] = (sg == 0) ? (v[e] * c - pv[e] * s) : (pv[e] * s + v[e] * c);
                       }
                     }
                     store16bf(KR + (size_t)row * 32 + (col - 768), v);
                   }
                 });
    } break;
    case PH_L2_QKV: {
      const bfu* ZQ = (const bfu*)big;
      const bfu* ZKV = ZQ + (size_t)M * 512;
      const float* SS = (const float*)(p.ws + OFF_SS);
      bfu* QN = (bfu*)(big + SLOT);
      bfu* QR = (bfu*)(big + 2 * SLOT);
      bfu* KN = (bfu*)(big + 3 * SLOT);
      bfu* Vb = (bfu*)(p.ws + OFF_EX);
      const float* cosC = (const float*)(p.ws + OFF_ROPEC); const float* sinC = cosC + 2048 * 16;
      const int ntq = 144 * 12, ntkv = 144 * 16;
      for (int t = blockIdx.x; t < ntq + ntkv; t += gridDim.x) {
        if (t < ntq) {
          const int mt = t / 12, nt = t - mt * 12;
          gemm_tile(smem, ALPlain{ZQ, 512}, Wt + WUQ, 512, 512, mt * 128, nt * 128,
                    [&](int row, int col, float (&v)[16]) {
                      const int b = row / TT, j = row - b * TT;
                      const float4 s4 = *(const float4*)(SS + (size_t)row * 8);
                      const float rinv = rsqrtf((s4.x + s4.y + s4.z + s4.w) * (1.f / 512.f) + 1e-6f);
#pragma unroll
                      for (int e = 0; e < 16; ++e) v[e] *= rinv;
                      float pv[16];
#pragma unroll
                      for (int e = 0; e < 16; ++e) pv[e] = xor1(v[e]);
                      if (col < 1024) {
                        store16bf(QN + (size_t)row * D + col, v);
                      } else {
                        const int sg = (col >> 4) & 1;
                        if (j >= CL) {
                          const int tk = j - CL;
#pragma unroll
                          for (int e = 0; e < 16; ++e) {
                            const float c = cosC[tk * 16 + e], s = sinC[tk * 16 + e];
                            v[e] = (sg == 0) ? (v[e] * c - pv[e] * s) : (pv[e] * s + v[e] * c);
                          }
                        }
                        store16bf(QR + (size_t)row * 512 + (col - 1024), v);
                      }
                    });
        } else {
          const int t2 = t - ntq;
          const int mt = t2 >> 4, nt = t2 & 15;
          gemm_tile(smem, ALPlain{ZKV, 256}, Wt + WUKV, 256, 256, mt * 128, nt * 128,
                    [&](int row, int col, float (&v)[16]) {
                      const float rinv = rsqrtf((SS[(size_t)row * 8 + 4] + SS[(size_t)row * 8 + 5]) * (1.f / 256.f) + 1e-6f);
#pragma unroll
                      for (int e = 0; e < 16; ++e) v[e] *= rinv;
                      if (col < 1024) store16bf(KN + (size_t)row * D + col, v);
                      else store16bf(Vb + (size_t)row * D + (col - 1024), v);
                    });
        }
      }
    } break;
    case PH_L2_ATT: {
      bfu* QN = (bfu*)(big + SLOT);
      const bfu* QR = (const bfu*)(big + 2 * SLOT);
      const bfu* KN = (const bfu*)(big + 3 * SLOT);
      const bfu* KR = (const bfu*)(p.ws + OFF_TW);
      const bfu* Vb = (const bfu*)(p.ws + OFF_EX);
      attn_mfma<32>(smem, QN, (bfu*)big, QR, KN, D, KR, Vb, D, 0.10206207261596577f * 1.4426950408889634f);
    } break;
    case PH_L2_OUT: out_phase(p, smem, 2, (const bfu*)big, WOUT2, false); break;
    case PH_L2_NORM2: norm_phase(p, smem, 2, 1, -1, false, 2, 2); break;
    case PH_L2_UP: mlp_up_phase(p, smem, false); break;
    case PH_L2_DOWN: mlp_down_phase(p, smem, 2, false); break;
    case PH_L3_NORM1: norm_phase(p, smem, 3, 0, 3, false, 2, 5); break;
    case PH_L3_IN: {
      bfu* GQ = (bfu*)big; bfu* GK = GQ + (size_t)M * 512;
      bfu* GV = (bfu*)(big + SLOT); bfu* GO = (bfu*)(big + 2 * SLOT);
      float* GD = (float*)(p.ws + OFF_GD);
      gemm_phase(smem, [&](int) { return ALPlain{U, D}; }, Wt + WIN3, 1024, 25, false,
                 [&](int row, int col, float (&v)[16]) {
                   if (col < 512) {
#pragma unroll
                     for (int e = 0; e < 16; ++e) v[e] *= 0.08838834764831845f;
                     store16bf(GQ + (size_t)row * 512 + col, v);
                   } else if (col < 1024) {
                     store16bf(GK + (size_t)row * 512 + (col - 512), v);
                   } else if (col < 2048) {
                     store16bf(GV + (size_t)row * D + (col - 1024), v);
                   } else if (col < 3072) {
                     store16bf(GO + (size_t)row * D + (col - 2048), v);
                   } else if (col < 3104) {
                     float* d = GD + (size_t)row * 32 + (col - 3072);
#pragma unroll
                     for (int q = 0; q < 4; ++q) *(float4*)(d + 4 * q) = make_float4(v[4 * q], v[4 * q + 1], v[4 * q + 2], v[4 * q + 3]);
                   }
                 });
    } break;
    case PH_L3_SCAN: gla_scan(p, smem); break;
    case PH_L3_POST: gla_post(p); break;
    case PH_L3_OUT: out_phase(p, smem, 3, (const bfu*)big, WOUT3, true); break;
    case PH_L3_NORM2: norm_phase(p, smem, 3, 1, -1, true); break;
    case PH_L3_UP: mlp_up_phase(p, smem, true); break;
    case PH_L3_DOWN: mlp_down_phase(p, smem, 3, true); break;
    case PH_FINAL: {
      const int lane = threadIdx.x & 63, wave = threadIdx.x >> 6;
      const float* gn = p.in[60];
      for (int it = blockIdx.x; it < NB * 2048 / 4; it += gridDim.x) {
        const int orow = it * 4 + wave;
        const int b = orow >> 11, t = orow & 2047;
        const float* xr = (const float*)(p.ws + OFF_XR) + ((size_t)b * TT + CL + t) * D;
        float4 x[4];
        float ss = 0.f;
#pragma unroll
        for (int i = 0; i < 4; ++i) {
          x[i] = *(const float4*)(xr + (i * 64 + lane) * 4);
          ss += x[i].x * x[i].x + x[i].y * x[i].y + x[i].z * x[i].z + x[i].w * x[i].w;
        }
        ss = wave_sum(ss);
        const float rinv = rsqrtf(ss * (1.f / 1024.f) + 1e-6f);
        float* o = p.out + (size_t)orow * D;
#pragma unroll
        for (int i = 0; i < 4; ++i) {
          const int c = (i * 64 + lane) * 4;
          const float4 g4 = *(const float4*)(gn + c);
          *(float4*)(o + c) = make_float4(x[i].x * rinv * g4.x, x[i].y * rinv * g4.y, x[i].z * rinv * g4.z, x[i].w * rinv * g4.w);
        }
      }
    } break;
    default: break;
  }
}


#define XB_TMO      128
#define XB_XCNT(j)  (256  + 64 * (j))
#define XB_XSUB(j)  (1280 + 64 * (j))
#define XB_XGEN(j)  (2304 + 64 * (j))
#define XB_TOP      3328
#define XB_TOPGEN   3392
#define XCD_BAR_WORDS 3456
#define XB_SPIN_CAP (1u << 22)
#define LAS __attribute__((address_space(3)))
DEVI unsigned xb_ld(unsigned* p) { return __hip_atomic_load(p, __ATOMIC_RELAXED, __HIP_MEMORY_SCOPE_AGENT); }
DEVI unsigned xb_add(unsigned* p, unsigned v) { return __hip_atomic_fetch_add(p, v, __ATOMIC_RELAXED, __HIP_MEMORY_SCOPE_AGENT); }
DEVI unsigned xb_xcc_id() { return (unsigned)__builtin_amdgcn_s_getreg((3 << 11) | 20) & 0xFu; }
#define XB_SPIN(cond, bar) do { unsigned _sp = 0; while (cond) { __builtin_amdgcn_s_sleep(1); \
    if ((++_sp & 255u) == 0u) { if (xb_ld(&(bar)[XB_TMO])) break; if (_sp > XB_SPIN_CAP) { atomicAdd(&(bar)[XB_TMO], 1u); break; } } } } while (0)
struct XcdBarrier { unsigned* bar; unsigned x; volatile LAS unsigned* st; };
DEVI XcdBarrier xcd_barrier_post(unsigned* bar, volatile LAS unsigned* st) {
  XcdBarrier b; b.bar = bar; b.x = xb_xcc_id(); b.st = st;
  if (threadIdx.x == 0) (void)xb_add(&bar[XB_XCNT(b.x)], 1u);
  return b;
}
DEVI void xcd_barrier_complete(unsigned* bar, unsigned x, unsigned& nloc, unsigned& nx) {
  const unsigned G = gridDim.x * gridDim.y * gridDim.z;
  unsigned sum, cnt, mine, sp = 0u;
  for (;;) {
    sum = 0u; cnt = 0u; mine = 0u;
#pragma unroll
    for (unsigned j = 0; j < 16; ++j) { const unsigned c = xb_ld(&bar[XB_XCNT(j)]); sum += c; cnt += (c > 0u) ? 1u : 0u; mine = (j == x) ? c : mine; }
    if (sum == G) break;
    __builtin_amdgcn_s_sleep(1);
    if ((++sp & 255u) == 0u) { if (xb_ld(&bar[XB_TMO])) break; if (sp > XB_SPIN_CAP) { atomicAdd(&bar[XB_TMO], 1u); break; } }
  }
  nloc = mine > 0u ? mine : 1u; nx = cnt > 0u ? cnt : 1u;
}
DEVI void xcd_barrier(const XcdBarrier& b) {
  asm volatile("s_waitcnt vmcnt(0)" ::: "memory");
  __syncthreads();
  if (threadIdx.x == 0) {
    unsigned* bar = b.bar;
    __builtin_amdgcn_s_waitcnt(0);
    unsigned nloc = b.st[0], nx = b.st[1];
    if (nloc == 0u) { xcd_barrier_complete(bar, b.x, nloc, nx); b.st[0] = nloc; b.st[1] = nx; }
    const unsigned old = xb_add(&bar[XB_XSUB(b.x)], 1u);
    const unsigned gen = old / nloc;
    if (old + 1u == (gen + 1u) * nloc) {
      __builtin_amdgcn_fence(__ATOMIC_RELEASE, "agent");
      asm volatile("s_waitcnt vmcnt(0)" ::: "memory");
      const unsigned og = xb_add(&bar[XB_TOP], 1u);
      const unsigned tg = og / nx;
      if (og + 1u == (tg + 1u) * nx) xb_add(&bar[XB_TOPGEN], 1u);
      else XB_SPIN(xb_ld(&bar[XB_TOPGEN]) == tg, bar);
      __builtin_amdgcn_fence(__ATOMIC_ACQUIRE, "agent");
      xb_add(&bar[XB_XGEN(b.x)], 1u);
      asm volatile("s_waitcnt vmcnt(0)" ::: "memory");
    } else {
      XB_SPIN(xb_ld(&bar[XB_XGEN(b.x)]) == gen, bar);
      __builtin_amdgcn_fence(__ATOMIC_ACQUIRE, "agent");
      asm volatile("s_waitcnt vmcnt(0)" ::: "memory");
    }
  }
  __syncthreads();
}

__global__ void __launch_bounds__(NTHR, 2) mega_kernel(Params p) {
  extern __shared__ __attribute__((aligned(16))) unsigned char smem[];
  cg::grid_group grid = cg::this_grid();
  __shared__ uint4 xb_words;
  if (threadIdx.x == 0) xb_words = make_uint4(0u, 0u, 0u, 0u);
  __syncthreads();
  XcdBarrier xb;
  xb.bar = (unsigned*)(p.ws + WS_BAR); xb.x = xb_xcc_id(); xb.st = (volatile LAS unsigned*)&xb_words;
  unsigned my_rank = 0;
  if (threadIdx.x == 0) my_rank = xb_add(&xb.bar[XB_XCNT(xb.x)], 1u);
  if (threadIdx.x == 0) xmap_ref() = make_int4((int)(blockIdx.x & 7), (int)(blockIdx.x >> 3), 0, 0);
  if (p.ph_lo < 0) grid.sync();
#define GSYNC(PH) xcd_barrier(xb)
#define RUN(PH) if (p.ph_lo <= (PH) && (PH) < p.ph_hi) { \
    if (PROBE_DUP(PH)) { run_phase<PH>(p, smem); xcd_barrier(xb); } \
    run_phase<PH>(p, smem); if ((PH) + 1 < p.ph_hi) GSYNC(PH); }
  RUN(0)
  if (threadIdx.x == 0) {
    bool ok = (gridDim.x & 7) == 0;
    for (unsigned j = 0; j < 8; ++j) ok = ok && (xb_ld(&xb.bar[XB_XCNT(j)]) == (gridDim.x >> 3));
    if (ok) xmap_ref() = make_int4((int)xb.x, (int)my_rank, 1, 0);
  }
  __syncthreads();
  RUN(1) RUN(2) RUN(3) RUN(4) RUN(5) RUN(6) RUN(7) RUN(8) RUN(9) RUN(10) RUN(11) RUN(12) RUN(13) RUN(14) RUN(15) RUN(16)
  RUN(17) RUN(18) RUN(19) RUN(20) RUN(21) RUN(22) RUN(23) RUN(24) RUN(25) RUN(26) RUN(27) RUN(28) RUN(29) RUN(30) RUN(31) RUN(32) RUN(33) RUN(34)
#undef RUN
  static_assert(NPHASES == 35, "phase count");
#ifdef PROBE_SYNCS
  for (int i = 0; i < PROBE_SYNCS; ++i) grid.sync();
#endif
}

extern "C" void kernel_launch(void* const* d_in, const int* in_sizes, int n_in, void* d_out, int out_size,
                              void* d_ws, size_t ws_size, hipStream_t stream) {
  static int grid_blocks = 0;
  if (grid_blocks == 0) {
    if (n_in != 61 || ws_size < WS_END) {
      fprintf(stderr, "kernel_launch: need 61 inputs and >= %zu bytes of workspace (got %d, %zu)\n", (size_t)WS_END, n_in, ws_size);
      grid_blocks = -1;
      return;
    }
    int dev = 0, cus = 0, per_cu = 0;
    hipGetDevice(&dev);
    hipDeviceGetAttribute(&cus, hipDeviceAttributeMultiprocessorCount, dev);
    hipFuncSetAttribute((const void*)mega_kernel, hipFuncAttributeMaxDynamicSharedMemorySize, LDS_BYTES);
    hipOccupancyMaxActiveBlocksPerMultiprocessor(&per_cu, (const void*)mega_kernel, NTHR, LDS_BYTES);
    if (per_cu < 1) { fprintf(stderr, "kernel_launch: occupancy query returned %d\n", per_cu); grid_blocks = -1; return; }
    if (per_cu > 2) per_cu = 2;
    grid_blocks = cus * per_cu;
  }
  if (grid_blocks < 0) return;
  (void)hipMemsetAsync((char*)d_ws + WS_BAR, 0, 16384, stream);
  Params p{};
  for (int i = 0; i < 61; ++i) p.in[i] = (const float*)d_in[i];
  p.out = (float*)d_out;
  p.ws = (unsigned char*)d_ws;
  p.ph_lo = 0;
  p.ph_hi = NPHASES;
  void* args[] = {&p};
  hipError_t e = hipLaunchCooperativeKernel((const void*)mega_kernel, dim3(grid_blocks), dim3(NTHR), args, LDS_BYTES, stream);
  if (e != hipSuccess) fprintf(stderr, "cooperative launch failed: %s (grid %d)\n", hipGetErrorString(e), grid_blocks);
}
```
